# Optimizing an MI355X kernel written in HIP

```python
import jax, jax.numpy as jnp
from jax import lax
import numpy as np

D_MODEL = 2048
BATCH = 1
SEQ = 8192
DEPTH = 4

GRID_W = 64
CTX_LEN = 256
N_MIXERS = 2
MIXER_MLA = 0
MIXER_FOURIER = 1
N_MLA_LAYERS = (DEPTH + 1) // 2
N_FNO_LAYERS = DEPTH // 2
N_HEADS = 16
Q_LORA = 512
KV_LORA = 512
QK_NOPE = 128
QK_ROPE = 64
V_DIM = 128
ROPE_BASE = 10000.0
Q_BLOCK = 128
SM_SCALE = (QK_NOPE + QK_ROPE) ** -0.5
FNO_GROUPS = 8
FNO_GROUP_DIM = D_MODEL // FNO_GROUPS
D_FF = 5632
CONV_W = 3
NORM_EPS = 1e-6
N_MOD = 6

kernel_name = "hybrid_mla_fnet_convffn_dit"


def _rmsnorm(x, g):
    xf = x.astype(jnp.float32)
    y = xf * lax.rsqrt(jnp.mean(xf * xf, axis=-1, keepdims=True) + NORM_EPS)
    return (y * g.astype(jnp.float32)).astype(x.dtype)


def _ada(cond, w, b):
    m = jax.nn.silu(cond) @ w + b
    m = m.reshape(m.shape[:-1] + (N_MOD, D_MODEL))
    return jnp.split(m, N_MOD, axis=-2)


def _modulate(h, shift, scale):
    return h * (1 + scale) + shift


def _axial_rope_tables(n, dtype):
    rows = n // GRID_W
    r, col = jnp.meshgrid(jnp.arange(rows, dtype=jnp.float32),
                          jnp.arange(GRID_W, dtype=jnp.float32), indexing="ij")
    r = r.reshape(-1)
    col = col.reshape(-1)
    half = QK_ROPE // 2
    inv_freq = jnp.power(ROPE_BASE, -jnp.arange(0, half, 2, dtype=jnp.float32) / half)
    ang_r = r[:, None] * inv_freq
    ang_c = col[:, None] * inv_freq
    ang = jnp.concatenate([ang_r, ang_r, ang_c, ang_c], axis=-1)
    return jnp.cos(ang).astype(dtype), jnp.sin(ang).astype(dtype)


def _rotate_axial(u):
    half = QK_ROPE // 2
    q = half // 2
    a1, a2 = u[..., :q], u[..., q:half]
    b1, b2 = u[..., half:half + q], u[..., half + q:]
    return jnp.concatenate([-a2, a1, -b2, b1], axis=-1)


def _apply_rope(u, cos, sin):
    return u * cos + _rotate_axial(u) * sin


def _mla_down(h, w_dqkv):
    d = h @ w_dqkv
    return d[..., :Q_LORA], d[..., Q_LORA:Q_LORA + KV_LORA], d[..., Q_LORA + KV_LORA:]


def _mla_queries(c_q, g_q, w_uq):
    b, n, _ = c_q.shape
    q = (_rmsnorm(c_q, g_q) @ w_uq).reshape(b, n, N_HEADS, QK_NOPE + QK_ROPE)
    return q[..., :QK_NOPE], q[..., QK_NOPE:]


def _mla_keys(c_kv, g_kv, w_ukv):
    b, n, _ = c_kv.shape
    kv = (_rmsnorm(c_kv, g_kv) @ w_ukv).reshape(b, n, N_HEADS, QK_NOPE + V_DIM)
    return kv[..., :QK_NOPE], kv[..., QK_NOPE:]


def _attend(qn, qr, kn, kr, v):
    s = jnp.einsum("bqhd,bkhd->bhqk", qn, kn) + jnp.einsum("bqhr,bkr->bhqk", qr, kr)
    p = jax.nn.softmax(s.astype(jnp.float32) * SM_SCALE, axis=-1).astype(v.dtype)
    return jnp.einsum("bhqk,bkhd->bqhd", p, v)


def _mla(hx, hc, w_dqkv, g_q, g_kv, w_uq, w_ukv, w_o, cos, sin, ctx_out):
    b, n, _ = hx.shape
    cq_x, ckv_x, kr_x = _mla_down(hx, w_dqkv)
    qn_x, qr_x = _mla_queries(cq_x, g_q, w_uq)
    qr_x = _apply_rope(qr_x, cos[None, :, None, :], sin[None, :, None, :])
    kn_x, v_x = _mla_keys(ckv_x, g_kv, w_ukv)
    kr_x = _apply_rope(kr_x, cos[None], sin[None])
    cq_c, ckv_c, kr_c = _mla_down(hc, w_dqkv)
    kn_c, v_c = _mla_keys(ckv_c, g_kv, w_ukv)
    kn = jnp.concatenate([kn_c, kn_x], axis=1)
    kr = jnp.concatenate([kr_c, kr_x], axis=1)
    v = jnp.concatenate([v_c, v_x], axis=1)
    nb = n // Q_BLOCK

    def to_blocks(t):
        return jnp.moveaxis(t.reshape((b, nb, Q_BLOCK) + t.shape[2:]), 1, 0)

    def block(qs):
        qn_b, qr_b = qs
        return _attend(qn_b, qr_b, kn, kr, v)

    o = lax.map(block, (to_blocks(qn_x), to_blocks(qr_x)))
    o = jnp.moveaxis(o, 0, 1).reshape(b, n, N_HEADS * V_DIM)
    yx = o @ w_o
    yc = None
    if ctx_out:
        qn_c, qr_c = _mla_queries(cq_c, g_q, w_uq)
        oc = _attend(qn_c, qr_c, kn_c, kr_c, v_c)
        yc = oc.reshape(b, hc.shape[1], N_HEADS * V_DIM) @ w_o
    return yx, yc


def _fourier_mix(h, w):
    b, n, _ = h.shape
    hg = h.astype(jnp.float32).reshape(b, n, FNO_GROUPS, FNO_GROUP_DIM)
    f = jnp.fft.fft2(hg, axes=(1, 3), norm="ortho").real
    return f.reshape(b, n, D_MODEL).astype(h.dtype) @ w


def _dwconv3(u, w, bias):
    up = jnp.pad(u, ((0, 0), (1, 1), (0, 0)))
    return up[:, :-2] * w[0] + up[:, 1:-1] * w[1] + up[:, 2:] * w[2] + bias


def _conv_ffn(h, w_up, conv_w, conv_b, w_down):
    u = _dwconv3(h @ w_up, conv_w, conv_b)
    val, gate = jnp.split(u, 2, axis=-1)
    return (val * jax.nn.silu(gate)) @ w_down


def setup_inputs(seed: int = 0) -> dict:
    key = jax.random.key(seed)
    ks = jax.random.split(key, 20)
    nrm = jax.random.normal
    f32 = jnp.float32
    D = D_MODEL
    return {
        "x": nrm(ks[0], (BATCH, SEQ, D), f32),
        "c": nrm(ks[1], (BATCH, D), f32),
        "ctx": nrm(ks[2], (BATCH, CTX_LEN, D), f32),
        "c_ctx": nrm(ks[3], (D,), f32),
        "ada_w": nrm(ks[4], (DEPTH, D, N_MOD * D), f32) * D ** -0.5,
        "ada_b": nrm(ks[5], (DEPTH, N_MOD * D), f32) * 0.02,
        "norm1_g": 1.0 + 0.02 * nrm(ks[6], (DEPTH, D), f32),
        "norm2_g": 1.0 + 0.02 * nrm(ks[7], (DEPTH, D), f32),
        "mla_w_dqkv": nrm(ks[8], (N_MLA_LAYERS, D, Q_LORA + KV_LORA + QK_ROPE), f32) * D ** -0.5,
        "mla_q_norm_g": 1.0 + 0.02 * nrm(ks[9], (N_MLA_LAYERS, Q_LORA), f32),
        "mla_kv_norm_g": 1.0 + 0.02 * nrm(ks[10], (N_MLA_LAYERS, KV_LORA), f32),
        "mla_w_uq": nrm(ks[11], (N_MLA_LAYERS, Q_LORA, N_HEADS * (QK_NOPE + QK_ROPE)), f32) * Q_LORA ** -0.5,
        "mla_w_ukv": nrm(ks[12], (N_MLA_LAYERS, KV_LORA, N_HEADS * (QK_NOPE + V_DIM)), f32) * KV_LORA ** -0.5,
        "mla_w_o": nrm(ks[13], (N_MLA_LAYERS, N_HEADS * V_DIM, D), f32) * (N_HEADS * V_DIM) ** -0.5,
        "fno_w": nrm(ks[14], (N_FNO_LAYERS, D, D), f32) * D ** -0.5,
        "ffn_w_up": nrm(ks[15], (DEPTH, D, 2 * D_FF), f32) * D ** -0.5,
        "ffn_conv_w": nrm(ks[16], (DEPTH, CONV_W, 2 * D_FF), f32) * CONV_W ** -0.5,
        "ffn_conv_b": nrm(ks[17], (DEPTH, 2 * D_FF), f32) * 0.02,
        "ffn_w_down": nrm(ks[18], (DEPTH, D_FF, D), f32) * D_FF ** -0.5,
        "final_norm_g": 1.0 + 0.02 * nrm(ks[19], (D,), f32),
    }


def reference(x, c, ctx, c_ctx, ada_w, ada_b, norm1_g, norm2_g, mla_w_dqkv, mla_q_norm_g,
              mla_kv_norm_g, mla_w_uq, mla_w_ukv, mla_w_o, fno_w, ffn_w_up, ffn_conv_w,
              ffn_conv_b, ffn_w_down, final_norm_g):
    n = x.shape[1]
    cos, sin = _axial_rope_tables(n, x.dtype)
    for i in range(DEPTH):
        kind = i % N_MIXERS
        j = i // N_MIXERS
        ctx_later = any(l % N_MIXERS == MIXER_MLA for l in range(i + 1, DEPTH))
        sh1, sc1, g1, sh2, sc2, g2 = _ada(c, ada_w[i], ada_b[i])
        hx = _modulate(_rmsnorm(x, norm1_g[i]), sh1, sc1)
        hc = None
        if kind == MIXER_MLA or ctx_later:
            csh1, csc1, cg1, csh2, csc2, cg2 = _ada(c_ctx, ada_w[i], ada_b[i])
            hc = _modulate(_rmsnorm(ctx, norm1_g[i]), csh1, csc1)
        if kind == MIXER_MLA:
            yx, yc = _mla(hx, hc, mla_w_dqkv[j], mla_q_norm_g[j], mla_kv_norm_g[j], mla_w_uq[j],
                          mla_w_ukv[j], mla_w_o[j], cos, sin, ctx_later)
        else:
            yx = _fourier_mix(hx, fno_w[j])
            yc = _fourier_mix(hc, fno_w[j]) if ctx_later else None
        x = x + g1 * yx
        x = x + g2 * _conv_ffn(_modulate(_rmsnorm(x, norm2_g[i]), sh2, sc2),
                               ffn_w_up[i], ffn_conv_w[i], ffn_conv_b[i], ffn_w_down[i])
        if ctx_later:
            ctx = ctx + cg1 * yc
            ctx = ctx + cg2 * _conv_ffn(_modulate(_rmsnorm(ctx, norm2_g[i]), csh2, csc2),
                                        ffn_w_up[i], ffn_conv_w[i], ffn_conv_b[i], ffn_w_down[i])
    return _rmsnorm(x, final_norm_g)
```

```cpp
#include <hip/hip_runtime.h>
#include <hip/hip_bf16.h>
#include <cstdio>
#include <cstdint>
#include <cmath>
namespace pg8 {
#define PG8_LAS __attribute__((address_space(3)))
typedef unsigned short bf16_t;
typedef short bf16x8 __attribute__((ext_vector_type(8)));
typedef float f32x4 __attribute__((ext_vector_type(4)));
typedef unsigned u32x4 __attribute__((ext_vector_type(4)));
constexpr int BM = 256, BK = 64, HALF = 128, HTB = HALF * BK * 2  , STAGE_BYTES = 8 * HTB, NXCD = 8, WGM = 8;

__host__ __device__ __forceinline__ int lds_byte(int r, int c) { const int st = (r >> 4) * 2 + (c >> 5), rr = r & 15, cc = c & 31, ob = rr * 64 + cc * 2; return st * 1024 + (ob ^ (((ob >> 9) & 1) << 5)); }
__host__ __device__ __forceinline__ void stage_rc(int b, int& R, int& C) { const int st = b / 1024, sb = b % 1024, swz = sb ^ (((sb >> 9) & 1) << 5); R = (st >> 1) * 16 + swz / 64; C = (st & 1) * 32 + (swz % 64) / 2; }
__host__ __device__ __forceinline__ int perm32(int rho) { const int n = rho >> 4, i = rho & 15; return 8 * (i >> 2) + 4 * n + (i & 3); }

struct Unit { int pm, pn, z; };
struct Gemm { const bf16_t* A; const bf16_t* Bt; int lda, ldb, K; long sAz, sBz, sBm; };

struct Order {
    int nM, nN, nMN, ntot, G, c;
    __device__ __forceinline__ void init(int nM_, int nN_, int nZ, int G_, int c_) { nM = nM_; nN = nN_; nMN = nM_ * nN_; ntot = nMN * nZ; G = G_; c = c_; asm volatile("" : "+s"(c)); }
    __device__ __forceinline__ bool next(int i, Unit& u) const {
        const int L = i * G + c; if (L >= ntot) return false;
        u.z = L / nMN; int wgid = L - u.z * nMN;
        { const int q = nMN / NXCD, r = nMN % NXCD, xcd = wgid % NXCD, off = wgid / NXCD; wgid = (xcd < r ? xcd * (q + 1) : r * (q + 1) + (xcd - r) * q) + off; }
        const int nig = WGM * nN, gid = wgid / nig, fm = gid * WGM, gsz = (nM - fm) < WGM ? (nM - fm) : WGM;
        u.pm = fm + ((wgid % nig) % gsz); u.pn = (wgid % nig) / gsz; return true;
    }
};

struct Order2 {
    int nM0, nN0, n0, nM1, nN1, n1, G, c;
    __device__ __forceinline__ void init(int nM0_, int nN0_, int nM1_, int nN1_, int G_, int c_) { nM0 = nM0_; nN0 = nN0_; n0 = nM0_ * nN0_; nM1 = nM1_; nN1 = nN1_; n1 = nM1_ * nN1_; G = G_; c = c_; asm volatile("" : "+s"(c)); }
    __device__ __forceinline__ bool next(int i, Unit& u) const {
        const int L = i * G + c; if (L >= n0 + n1) return false;
        const bool p1 = L >= n0; u.z = p1 ? 1 : 0; int wgid = p1 ? L - n0 : L; const int nM = p1 ? nM1 : nM0, nN = p1 ? nN1 : nN0, nMN = p1 ? n1 : n0;
        { const int q = nMN / NXCD, r = nMN % NXCD, xcd = wgid % NXCD, off = wgid / NXCD; wgid = (xcd < r ? xcd * (q + 1) : r * (q + 1) + (xcd - r) * q) + off; }
        const int nig = WGM * nN, gid = wgid / nig, fm = gid * WGM, gsz = (nM - fm) < WGM ? (nM - fm) : WGM;
        u.pm = fm + ((wgid % nig) % gsz); u.pn = (wgid % nig) / gsz; return true;
    }
};

__device__ __forceinline__ unsigned cvt_pk_bf16(float lo, float hi) { unsigned r; asm volatile("v_cvt_pk_bf16_f32 %0, %1, %2" : "=v"(r) : "v"(lo), "v"(hi)); return r; }

struct EpiBf16 {
    static constexpr bool PERM = true, APERM = false;
    bf16_t* O; int ldc; long zs; int dldc;
    __device__ __forceinline__ void operator()(const f32x4 (&acc)[2][2][4][2], const Unit& u, int wr, int wc, int fr, int fq) const {
        const int row0 = u.pm * BM + wr * 64 + fr, col0 = u.pn * BM + wc * 32 + 8 * fq, ld = ldc + u.z * dldc;
#pragma unroll
        for (int ai = 0; ai < 2; ++ai)
#pragma unroll
            for (int m = 0; m < 4; ++m) { bf16_t* rowp = O + (size_t)u.z * zs + (size_t)(row0 + ai * HALF + m * 16) * ld + col0;
#pragma unroll
                for (int bj = 0; bj < 2; ++bj) { const f32x4 v0 = acc[ai][bj][m][0], v1 = acc[ai][bj][m][1];
                    u32x4 w; w.x = cvt_pk_bf16(v0[0], v0[1]); w.y = cvt_pk_bf16(v0[2], v0[3]); w.z = cvt_pk_bf16(v1[0], v1[1]); w.w = cvt_pk_bf16(v1[2], v1[3]);
                    *(u32x4*)(rowp + bj * HALF) = w; } }
    }
};
struct EpiChDft {
    static constexpr bool PERM = true, APERM = false;
    bf16_t* Y; int ldy; int part_stride;
    __device__ __forceinline__ void operator()(const f32x4 (&acc)[2][2][4][2], const Unit& u, int wr, int wc, int fr, int fq) const {
        const int row0 = u.z * BM + wr * 64 + fr, col0 = u.pm * part_stride + u.pn * BM + wc * 32 + 8 * fq;
#pragma unroll
        for (int ai = 0; ai < 2; ++ai)
#pragma unroll
            for (int m = 0; m < 4; ++m) { bf16_t* rowp = Y + (size_t)(row0 + ai * HALF + m * 16) * ldy + col0;
#pragma unroll
                for (int bj = 0; bj < 2; ++bj) { const f32x4 v0 = acc[ai][bj][m][0], v1 = acc[ai][bj][m][1];
                    u32x4 w; w.x = cvt_pk_bf16(v0[0], v0[1]); w.y = cvt_pk_bf16(v0[2], v0[3]); w.z = cvt_pk_bf16(v1[0], v1[1]); w.w = cvt_pk_bf16(v1[2], v1[3]);
                    *(u32x4*)(rowp + bj * HALF) = w; } }
    }
};
struct EpiF32 {
    static constexpr bool PERM = false, APERM = false;
    float* C; int ldc;
    __device__ __forceinline__ void operator()(const f32x4 (&acc)[2][2][4][2], const Unit& u, int wr, int wc, int fr, int fq) const {
        const int row0 = u.pm * BM + wr * 64 + fr, col0 = u.pn * BM + wc * 32 + 4 * fq;
#pragma unroll
        for (int ai = 0; ai < 2; ++ai)
#pragma unroll
            for (int m = 0; m < 4; ++m) { float* rowp = C + (size_t)(row0 + ai * HALF + m * 16) * ldc + col0;
#pragma unroll
                for (int bj = 0; bj < 2; ++bj)
#pragma unroll
                    for (int n = 0; n < 2; ++n) *(f32x4*)(rowp + bj * HALF + n * 16) = acc[ai][bj][m][n]; }
    }
};
struct EpiResid {
    static constexpr bool PERM = true, APERM = false;
    bf16_t* X; int ldc; const float* gate_ctx; const float* gate_x; int ctx_tile0;
    __device__ __forceinline__ void operator()(const f32x4 (&acc)[2][2][4][2], const Unit& u, int wr, int wc, int fr, int fq) const {
        const int row0 = u.pm * BM + wr * 64 + fr, col0 = u.pn * BM + wc * 32 + 8 * fq;
        const float* gate = (ctx_tile0 && u.pm == 0) ? gate_ctx : gate_x;
        f32x4 gv[2][2];
#pragma unroll
        for (int bj = 0; bj < 2; ++bj)
#pragma unroll
            for (int n = 0; n < 2; ++n) gv[bj][n] = *(const f32x4*)(gate + col0 + bj * HALF + 4 * n);
#pragma unroll
        for (int ai = 0; ai < 2; ++ai)
#pragma unroll
            for (int m = 0; m < 4; ++m) { bf16_t* rowp = X + (size_t)(row0 + ai * HALF + m * 16) * ldc + col0;
#pragma unroll
                for (int bj = 0; bj < 2; ++bj) { const u32x4 xw = *(const u32x4*)(rowp + bj * HALF);
                    const f32x4 x0 = {__uint_as_float(xw.x << 16), __uint_as_float(xw.x & 0xffff0000u), __uint_as_float(xw.y << 16), __uint_as_float(xw.y & 0xffff0000u)};
                    const f32x4 x1 = {__uint_as_float(xw.z << 16), __uint_as_float(xw.z & 0xffff0000u), __uint_as_float(xw.w << 16), __uint_as_float(xw.w & 0xffff0000u)};
                    const f32x4 v0 = x0 + gv[bj][0] * acc[ai][bj][m][0], v1 = x1 + gv[bj][1] * acc[ai][bj][m][1];
                    u32x4 w; w.x = cvt_pk_bf16(v0[0], v0[1]); w.y = cvt_pk_bf16(v0[2], v0[3]); w.z = cvt_pk_bf16(v1[0], v1[1]); w.w = cvt_pk_bf16(v1[2], v1[3]);
                    *(u32x4*)(rowp + bj * HALF) = w; }
                if (m & 1) asm volatile("" ::: "memory"); }
    }
};

struct EpiGatePart {
    static constexpr bool PERM = false, APERM = false;
    float* P; int ldc; const float* gate;
    __device__ __forceinline__ void operator()(const f32x4 (&acc)[2][2][4][2], const Unit& u, int wr, int wc, int fr, int fq) const {
        const int row0 = u.z * BM + u.pm * BM + wr * 64 + fr, col0 = u.pn * BM + wc * 32 + 4 * fq;
        f32x4 gv[2][2];
#pragma unroll
        for (int bj = 0; bj < 2; ++bj)
#pragma unroll
            for (int n = 0; n < 2; ++n) gv[bj][n] = *(const f32x4*)(gate + col0 + bj * HALF + n * 16);
#pragma unroll
        for (int ai = 0; ai < 2; ++ai)
#pragma unroll
            for (int m = 0; m < 4; ++m) { float* rowp = P + (size_t)(row0 + ai * HALF + m * 16) * ldc + col0;
#pragma unroll
                for (int bj = 0; bj < 2; ++bj)
#pragma unroll
                    for (int n = 0; n < 2; ++n) *(f32x4*)(rowp + bj * HALF + n * 16) = gv[bj][n] * acc[ai][bj][m][n]; }
    }
};

template <int CTRL> __device__ __forceinline__ float dpp_keep(float old, float src) {
    return __builtin_bit_cast(float, __builtin_amdgcn_update_dpp(__builtin_bit_cast(int, old), __builtin_bit_cast(int, src), CTRL, 0xf, 0xf, false));
}
typedef float f32x2 __attribute__((ext_vector_type(2)));
struct EpiConvGate {
    static constexpr bool PERM = true, APERM = true;
    bf16_t* ACT; int ldact; const float* cws; int nup, dff; float* EDGE; PG8_LAS float* xch;
    __device__ __forceinline__ void operator()(const f32x4 (&acc)[2][2][4][2], const Unit& u, int wr, int wc, int fr, int fq) const {
        const int cl = wc * 32 + 8 * fq, colb = u.pn * 128 + cl;
        f32x4 wq[2][2][3], bq[2][2];
#pragma unroll
        for (int n = 0; n < 2; ++n)
#pragma unroll
            for (int bj = 0; bj < 2; ++bj) { bq[n][bj] = *(const f32x4*)(cws + (size_t)3 * nup + bj * dff + colb + 4 * n);
#pragma unroll
                for (int tp = 0; tp < 3; ++tp) wq[n][bj][tp] = *(const f32x4*)(cws + (size_t)tp * nup + bj * dff + colb + 4 * n); }
        if (fr == 0) {
#pragma unroll
            for (int ai = 0; ai < 2; ++ai)
#pragma unroll
                for (int bj = 0; bj < 2; ++bj)
#pragma unroll
                    for (int n = 0; n < 2; ++n) *(PG8_LAS f32x4*)(xch + ((((wr * 2 + ai) * 2 + 0) * 2 + bj) * 128) + cl + 4 * n) = acc[ai][bj][0][n];
        }
        if (fr == 15) {
#pragma unroll
            for (int ai = 0; ai < 2; ++ai)
#pragma unroll
                for (int bj = 0; bj < 2; ++bj)
#pragma unroll
                    for (int n = 0; n < 2; ++n) *(PG8_LAS f32x4*)(xch + ((((wr * 2 + ai) * 2 + 1) * 2 + bj) * 128) + cl + 4 * n) = acc[ai][bj][3][n];
        }
        asm volatile("s_waitcnt lgkmcnt(0)" ::: "memory"); __builtin_amdgcn_s_barrier();
        const int ZB = 2048;
        const int top0 = wr == 1 ? (((0 * 2 + 0) * 2 + 1) * 2) * 128 : ZB, top1 = wr == 1 ? (((0 * 2 + 1) * 2 + 1) * 2) * 128 : (((1 * 2 + 0) * 2 + 1) * 2) * 128;
        const int bot0 = wr == 0 ? (((1 * 2 + 0) * 2 + 0) * 2) * 128 : (((0 * 2 + 1) * 2 + 0) * 2) * 128, bot1 = wr == 0 ? (((1 * 2 + 1) * 2 + 0) * 2) * 128 : ZB;
        unsigned op[2][4][2][2];
#pragma unroll
        for (int n = 0; n < 2; ++n) {
            const f32x4 (&w)[2][3] = wq[n]; const f32x4 (&b)[2] = bq[n];
#pragma unroll
            for (int ai = 0; ai < 2; ++ai) {
                f32x2 pre[2][4][2];
#pragma unroll
                for (int bj = 0; bj < 2; ++bj) {
                    const f32x4 ht = *(const PG8_LAS f32x4*)(xch + (ai == 0 ? top0 : top1) + bj * 128 + cl + 4 * n), hb = *(const PG8_LAS f32x4*)(xch + (ai == 0 ? bot0 : bot1) + bj * 128 + cl + 4 * n);
#pragma unroll
                    for (int jp = 0; jp < 2; ++jp) { const int j = 2 * jp;
                        const f32x2 u0 = {acc[ai][bj][0][n][j], acc[ai][bj][0][n][j + 1]}, u1 = {acc[ai][bj][1][n][j], acc[ai][bj][1][n][j + 1]}, u2 = {acc[ai][bj][2][n][j], acc[ai][bj][2][n][j + 1]}, u3 = {acc[ai][bj][3][n][j], acc[ai][bj][3][n][j + 1]};
                        const f32x2 pv = {dpp_keep<0x111>(ht[j], u3[0]), dpp_keep<0x111>(ht[j + 1], u3[1])};
                        const f32x2 nx = {dpp_keep<0x101>(hb[j], u0[0]), dpp_keep<0x101>(hb[j + 1], u0[1])};
                        const f32x2 w0 = {w[bj][0][j], w[bj][0][j + 1]}, w1 = {w[bj][1][j], w[bj][1][j + 1]}, w2 = {w[bj][2][j], w[bj][2][j + 1]}, bb = {b[bj][j], b[bj][j + 1]};
                        pre[bj][0][jp] = w2 * u1 + (w0 * pv + (w1 * u0 + bb));
                        pre[bj][1][jp] = w2 * u2 + (w0 * u0 + (w1 * u1 + bb));
                        pre[bj][2][jp] = w2 * u3 + (w0 * u1 + (w1 * u2 + bb));
                        pre[bj][3][jp] = w2 * nx + (w0 * u2 + (w1 * u3 + bb));
                    }
                }
                if (wr == 0 && ai == 0 && fr == 0) {
                    float* e = EDGE + (size_t)((u.pm * 2 + 0) * 2) * nup + colb + 4 * n;
                    *(f32x4*)(e) = (f32x4){pre[0][0][0][0], pre[0][0][0][1], pre[0][0][1][0], pre[0][0][1][1]}; *(f32x4*)(e + dff) = (f32x4){pre[1][0][0][0], pre[1][0][0][1], pre[1][0][1][0], pre[1][0][1][1]};
                    *(f32x4*)(e + nup) = acc[0][0][0][n]; *(f32x4*)(e + nup + dff) = acc[0][1][0][n];
                }
                if (wr == 1 && ai == 1 && fr == 15) {
                    float* e = EDGE + (size_t)((u.pm * 2 + 1) * 2) * nup + colb + 4 * n;
                    *(f32x4*)(e) = (f32x4){pre[0][3][0][0], pre[0][3][0][1], pre[0][3][1][0], pre[0][3][1][1]}; *(f32x4*)(e + dff) = (f32x4){pre[1][3][0][0], pre[1][3][0][1], pre[1][3][1][0], pre[1][3][1][1]};
                    *(f32x4*)(e + nup) = acc[1][0][3][n]; *(f32x4*)(e + nup + dff) = acc[1][1][3][n];
                }
#pragma unroll
                for (int m = 0; m < 4; ++m)
#pragma unroll
                    for (int jp = 0; jp < 2; ++jp) { const f32x2 t = pre[1][m][jp]; const f32x2 e2 = {__builtin_amdgcn_exp2f(t[0]), __builtin_amdgcn_exp2f(t[1])}; const f32x2 d = e2 + 1.0f;
                        const f32x2 r = {__builtin_amdgcn_rcpf(d[0]), __builtin_amdgcn_rcpf(d[1])}; const f32x2 o = (pre[0][m][jp] * t) * r;
                        op[ai][m][n][jp] = cvt_pk_bf16(o[0], o[1]); }
            }
        }
        char* abase = (char*)(ACT + (size_t)u.pm * BM * ldact);
        const unsigned vo = (unsigned)((wr * 64 + 4 * fr) * ldact + colb) * 2u;
#pragma unroll
        for (int ai = 0; ai < 2; ++ai)
#pragma unroll
            for (int m = 0; m < 4; ++m) { u32x4 wv; wv.x = op[ai][m][0][0]; wv.y = op[ai][m][0][1]; wv.z = op[ai][m][1][0]; wv.w = op[ai][m][1][1];
                *(u32x4*)(abase + (vo + (unsigned)((ai * HALF + m) * ldact) * 2u)) = wv; }
    }
};

struct EpiLatent {
    static constexpr bool PERM = true, APERM = false;
    bf16_t* CQ; bf16_t* CKV; bf16_t* KR; float* SSQ; const float* rope; int ctxl; PG8_LAS float* xch;
    __device__ __forceinline__ void operator()(const f32x4 (&acc)[2][2][4][2], const Unit& u, int wr, int wc, int fr, int fq) const {
        const int row0 = u.pm * BM + wr * 64 + fr, cl = wc * 32 + 8 * fq;
        if (u.pn < 4) {
            bf16_t* O = (u.pn < 2 ? CQ : CKV) + (u.pn & 1) * 256 + cl;
            float ss[2][4];
#pragma unroll
            for (int ai = 0; ai < 2; ++ai)
#pragma unroll
                for (int m = 0; m < 4; ++m) { bf16_t* rowp = O + (size_t)(row0 + ai * HALF + m * 16) * 512; float s = 0.f;
#pragma unroll
                    for (int bj = 0; bj < 2; ++bj) { const f32x4 v0 = acc[ai][bj][m][0], v1 = acc[ai][bj][m][1];
                        s += (v0[0] * v0[0] + v0[1] * v0[1]) + (v0[2] * v0[2] + v0[3] * v0[3]) + (v1[0] * v1[0] + v1[1] * v1[1]) + (v1[2] * v1[2] + v1[3] * v1[3]);
                        u32x4 w; w.x = cvt_pk_bf16(v0[0], v0[1]); w.y = cvt_pk_bf16(v0[2], v0[3]); w.z = cvt_pk_bf16(v1[0], v1[1]); w.w = cvt_pk_bf16(v1[2], v1[3]);
                        *(u32x4*)(rowp + bj * HALF) = w; }
                    ss[ai][m] = s; }
            const int lane = fq * 16 + fr;
#pragma unroll
            for (int ai = 0; ai < 2; ++ai)
#pragma unroll
                for (int m = 0; m < 4; ++m) { float s = ss[ai][m];
                    s += __builtin_bit_cast(float, __builtin_amdgcn_ds_bpermute((lane ^ 16) << 2, __builtin_bit_cast(int, s)));
                    s += __builtin_bit_cast(float, __builtin_amdgcn_ds_bpermute((lane ^ 32) << 2, __builtin_bit_cast(int, s)));
                    if (fq == 0) xch[((wr * 4 + wc) * 8 + ai * 4 + m) * 16 + fr] = s; }
        } else if (wc < 2) {
#pragma unroll
            for (int ai = 0; ai < 2; ++ai)
#pragma unroll
                for (int m = 0; m < 4; ++m) { const int row = row0 + ai * HALF + m * 16; f32x4 v0 = acc[ai][0][m][0], v1 = acc[ai][0][m][1];
                    if (row >= ctxl) { const float* rp = rope + (size_t)(row - ctxl) * 64 + cl; const f32x4 c0 = *(const f32x4*)(rp), c1 = *(const f32x4*)(rp + 4);
                        const f32x4 r0 = {v0[0] * c0[0] - v0[1] * c0[1], v0[1] * c0[0] + v0[0] * c0[1], v0[2] * c0[2] - v0[3] * c0[3], v0[3] * c0[2] + v0[2] * c0[3]};
                        const f32x4 r1 = {v1[0] * c1[0] - v1[1] * c1[1], v1[1] * c1[0] + v1[0] * c1[1], v1[2] * c1[2] - v1[3] * c1[3], v1[3] * c1[2] + v1[2] * c1[3]};
                        v0 = r0; v1 = r1; }
                    u32x4 w; w.x = cvt_pk_bf16(v0[0], v0[1]); w.y = cvt_pk_bf16(v0[2], v0[3]); w.z = cvt_pk_bf16(v1[0], v1[1]); w.w = cvt_pk_bf16(v1[2], v1[3]);
                    *(u32x4*)(KR + (size_t)row * 64 + cl) = w; }
        }
        asm volatile("s_waitcnt lgkmcnt(0)" ::: "memory"); __builtin_amdgcn_s_barrier();
        if (u.pn < 4 && wc == 0 && fq == 0) {
#pragma unroll
            for (int ai = 0; ai < 2; ++ai)
#pragma unroll
                for (int m = 0; m < 4; ++m) { float s = 0.f;
#pragma unroll
                    for (int w4 = 0; w4 < 4; ++w4) s += xch[((wr * 4 + w4) * 8 + ai * 4 + m) * 16 + fr];
                    SSQ[(size_t)(row0 + ai * HALF + m * 16) * 4 + u.pn] = s; }
        }
    }
};
struct EpiBf16RS {
    static constexpr bool PERM = true, APERM = false;
    bf16_t* O; int ldc; long zs; int dldc; const float* SSQ; int row_off0;
    __device__ __forceinline__ void operator()(const f32x4 (&acc)[2][2][4][2], const Unit& u, int wr, int wc, int fr, int fq) const {
        const int row0 = u.pm * BM + wr * 64 + fr, col0 = u.pn * BM + wc * 32 + 8 * fq, ld = ldc + u.z * dldc;
        const float* sq = SSQ + (size_t)(row0 + (u.z == 0 ? row_off0 : 0)) * 4 + 2 * u.z;
#pragma unroll
        for (int ai = 0; ai < 2; ++ai)
#pragma unroll
            for (int m = 0; m < 4; ++m) { bf16_t* rowp = O + (size_t)u.z * zs + (size_t)(row0 + ai * HALF + m * 16) * ld + col0;
                const float* sp = sq + (size_t)(ai * HALF + m * 16) * 4; const float rs = 1.0f / sqrtf((sp[0] + sp[1]) * (1.f / 512.f) + 1e-6f);
#pragma unroll
                for (int bj = 0; bj < 2; ++bj) { const f32x4 v0 = acc[ai][bj][m][0] * rs, v1 = acc[ai][bj][m][1] * rs;
                    u32x4 w; w.x = cvt_pk_bf16(v0[0], v0[1]); w.y = cvt_pk_bf16(v0[2], v0[3]); w.z = cvt_pk_bf16(v1[0], v1[1]); w.w = cvt_pk_bf16(v1[2], v1[3]);
                    *(u32x4*)(rowp + bj * HALF) = w; } }
    }
};

template <class Epi, class Sched, bool ALIGN_EPI = false, bool SP2 = false>
__device__ __forceinline__ void gemm_phase(PG8_LAS unsigned char* lds, const Gemm g, const Sched& S, const Epi& E, int wid  ) {
    int lane; asm volatile("v_mbcnt_lo_u32_b32 %0, -1, 0\n\tv_mbcnt_hi_u32_b32 %0, -1, %0" : "=v"(lane));
    const int tid = wid * 64 + lane, wr = wid >> 2, wc = wid & 3, fr = lane & 15, fq = lane >> 4;
    const int K = g.K, nt = K / BK;
    unsigned voffA[2], voffB[2];
#pragma unroll
    for (int i = 0; i < 2; ++i) { int R, C; stage_rc(tid * 16 + i * 8192, R, C); const int Rb = Epi::PERM ? ((R & ~31) + perm32(R & 31)) : R; const int Ra = Epi::APERM ? ((R & ~63) + 4 * (R & 15) + ((R >> 4) & 3)) : R;
        voffA[i] = (unsigned)(Ra * g.lda + C) * 2u; voffB[i] = (unsigned)(Rb * g.ldb + C) * 2u; }
    const size_t kstep = (size_t)(BK * 2);
    const size_t hstepA = (size_t)HALF * g.lda * 2, hstepB = (size_t)HALF * g.ldb * 2;
    const size_t tstepA = 2 * hstepA, tstepB = 2 * hstepB;
    const unsigned ldsw = (unsigned)wid * 1024u;
    const int aoff = lds_byte(wr * 64 + fr, fq * 8), boff = lds_byte(wc * 32 + fr, fq * 8);
#define PG8_SA(b, h) (((b) * 2 + (h)) * HTB)
#define PG8_SB(b, h) ((4 + (b) * 2 + (h)) * HTB)
#define PG8_STAGE(bufoff, gbase, voff) do { _Pragma("unroll") for (int _i = 0; _i < 2; ++_i) \
        __builtin_amdgcn_global_load_lds((const unsigned*)((const char*)(gbase) + (voff)[_i]), (PG8_LAS unsigned*)(lds + (bufoff) + ldsw + _i * 8192), 16, 0, 0); } while (0)
#define PG8_LDA(dst, b, h) do { _Pragma("unroll") for (int m = 0; m < 4; ++m) _Pragma("unroll") for (int k = 0; k < 2; ++k) dst[m][k] = *(const PG8_LAS bf16x8*)(lds + PG8_SA(b, h) + aoff + m * 2048 + k * 1024); } while (0)
#define PG8_LDB(dst, b, h) do { _Pragma("unroll") for (int n = 0; n < 2; ++n) _Pragma("unroll") for (int k = 0; k < 2; ++k) dst[n][k] = *(const PG8_LAS bf16x8*)(lds + PG8_SB(b, h) + boff + n * 2048 + k * 1024); } while (0)
#define PG8_MMA(ai, bj, At, Bt) do { __builtin_amdgcn_s_setprio(1); _Pragma("unroll") for (int m = 0; m < 4; ++m) _Pragma("unroll") for (int n = 0; n < 2; ++n) _Pragma("unroll") for (int k = 0; k < 2; ++k) \
        acc[ai][bj][m][n] = __builtin_amdgcn_mfma_f32_16x16x32_bf16(Bt[n][k], At[m][k], acc[ai][bj][m][n], 0, 0, 0); __builtin_amdgcn_s_setprio(0); } while (0)
#define PG8_WAIT_V(n) asm volatile("s_waitcnt vmcnt(" #n ")" ::: "memory")
#define PG8_WAIT_L(n) asm volatile("s_waitcnt lgkmcnt(" #n ")" ::: "memory")
#define PG8_BAR __builtin_amdgcn_s_barrier()
#define PG8_SCHED __builtin_amdgcn_sched_barrier(0)
    Unit cur, nxt; int ui = 0;
    if (!S.next(0, cur)) return;
    f32x4 acc[2][2][4][2];
#pragma unroll
    for (int a = 0; a < 2; ++a)
#pragma unroll
        for (int b = 0; b < 2; ++b)
#pragma unroll
            for (int m = 0; m < 4; ++m)
#pragma unroll
                for (int n = 0; n < 2; ++n) acc[a][b][m][n] = (f32x4){0.f, 0.f, 0.f, 0.f};
    bf16x8 At[4][2], B0[2][2], B1[2][2];
    const char* cA = (const char*)g.A + (size_t)cur.z * g.sAz + (size_t)cur.pm * tstepA; const char* cB = (const char*)g.Bt + (size_t)cur.z * g.sBz + (size_t)cur.pm * g.sBm + (size_t)cur.pn * tstepB;
    if constexpr (SP2) {
        PG8_STAGE(PG8_SB(0, 0), cB, voffB); PG8_STAGE(PG8_SB(0, 1), cB + hstepB, voffB); PG8_STAGE(PG8_SA(0, 0), cA, voffA); PG8_STAGE(PG8_SA(0, 1), cA + hstepA, voffA);
        if (wr == 1) PG8_BAR;
        PG8_WAIT_V(2); PG8_BAR;
        PG8_STAGE(PG8_SB(1, 0), cB + kstep, voffB); PG8_STAGE(PG8_SA(1, 0), cA + kstep, voffA); PG8_STAGE(PG8_SB(1, 1), cB + hstepB + kstep, voffB);
        PG8_WAIT_V(6); PG8_BAR;
    } else {
        PG8_STAGE(PG8_SB(0, 0), cB, voffB); PG8_STAGE(PG8_SA(0, 0), cA, voffA); PG8_STAGE(PG8_SB(0, 1), cB + hstepB, voffB); PG8_STAGE(PG8_SA(0, 1), cA + hstepA, voffA);
        if (wr == 1) PG8_BAR;
        PG8_WAIT_V(4); PG8_BAR;
        PG8_STAGE(PG8_SB(1, 0), cB + kstep, voffB); PG8_STAGE(PG8_SA(1, 0), cA + kstep, voffA); PG8_STAGE(PG8_SB(1, 1), cB + hstepB + kstep, voffB);
        PG8_WAIT_V(6); PG8_BAR;
    }
    for (;;) {
        const bool has_next = S.next(ui + 1, nxt);
        const char* nA = has_next ? (const char*)g.A + (size_t)nxt.z * g.sAz + (size_t)nxt.pm * tstepA : cA; const char* nB = has_next ? (const char*)g.Bt + (size_t)nxt.z * g.sBz + (size_t)nxt.pm * g.sBm + (size_t)nxt.pn * tstepB : cB;
        for (int t = 0; t < nt; t += 2) {
            const bool last = (t == nt - 2);
            const char* a1 = cA + (size_t)(t + 1) * kstep;
            const char* a2 = last ? nA : cA + (size_t)(t + 2) * kstep; const char* b2 = last ? nB : cB + (size_t)(t + 2) * kstep;
            const char* a3 = a2 + kstep; const char* b3 = b2 + kstep;
            if constexpr (SP2) {
            PG8_LDB(B0, 0, 0); PG8_LDB(B1, 0, 1); PG8_SCHED; PG8_LDA(At, 0, 0); PG8_STAGE(PG8_SA(1, 1), a1 + hstepA, voffA);
            PG8_WAIT_V(8); PG8_WAIT_L(0); PG8_BAR; PG8_MMA(0, 0, At, B0); PG8_MMA(0, 1, At, B1); PG8_BAR; PG8_SCHED;
            PG8_LDA(At, 0, 1); PG8_STAGE(PG8_SB(0, 0), b2, voffB); PG8_STAGE(PG8_SB(0, 1), b2 + hstepB, voffB); PG8_STAGE(PG8_SA(0, 0), a2, voffA);
            PG8_WAIT_V(8); PG8_WAIT_L(0); PG8_BAR; PG8_MMA(1, 0, At, B0); PG8_MMA(1, 1, At, B1); PG8_BAR; PG8_SCHED;
            PG8_LDB(B0, 1, 0); PG8_LDB(B1, 1, 1); PG8_SCHED; PG8_LDA(At, 1, 0); PG8_STAGE(PG8_SA(0, 1), a2 + hstepA, voffA);
            PG8_WAIT_V(8); PG8_WAIT_L(0); PG8_BAR; PG8_MMA(0, 0, At, B0); PG8_MMA(0, 1, At, B1); PG8_BAR; PG8_SCHED;
            PG8_LDA(At, 1, 1); PG8_STAGE(PG8_SB(1, 0), b3, voffB); PG8_STAGE(PG8_SB(1, 1), b3 + hstepB, voffB); PG8_STAGE(PG8_SA(1, 0), a3, voffA);
            PG8_WAIT_V(8); PG8_WAIT_L(0); PG8_BAR; PG8_MMA(1, 0, At, B0); PG8_MMA(1, 1, At, B1); PG8_BAR; PG8_SCHED;
            } else {
            PG8_LDB(B0, 0, 0); PG8_SCHED; PG8_LDA(At, 0, 0); PG8_STAGE(PG8_SA(1, 1), a1 + hstepA, voffA);
            PG8_WAIT_L(8); PG8_BAR; PG8_WAIT_L(0); PG8_MMA(0, 0, At, B0); PG8_BAR; PG8_SCHED;
            PG8_LDB(B1, 0, 1); PG8_STAGE(PG8_SB(0, 0), b2, voffB);
            PG8_BAR; PG8_WAIT_L(0); PG8_MMA(0, 1, At, B1); PG8_BAR;
            PG8_LDA(At, 0, 1); PG8_STAGE(PG8_SA(0, 0), a2, voffA);
            PG8_BAR; PG8_WAIT_L(0); PG8_MMA(1, 0, At, B0); PG8_BAR; PG8_SCHED;
            PG8_STAGE(PG8_SB(0, 1), b2 + hstepB, voffB);
            PG8_WAIT_V(6); PG8_BAR; PG8_MMA(1, 1, At, B1); PG8_BAR;
            PG8_LDB(B0, 1, 0); PG8_SCHED; PG8_LDA(At, 1, 0); PG8_STAGE(PG8_SA(0, 1), a2 + hstepA, voffA);
            PG8_WAIT_L(8); PG8_BAR; PG8_WAIT_L(0); PG8_MMA(0, 0, At, B0); PG8_BAR; PG8_SCHED;
            PG8_LDB(B1, 1, 1); PG8_STAGE(PG8_SB(1, 0), b3, voffB);
            PG8_BAR; PG8_WAIT_L(0); PG8_MMA(0, 1, At, B1); PG8_BAR;
            PG8_LDA(At, 1, 1); PG8_STAGE(PG8_SA(1, 0), a3, voffA);
            PG8_BAR; PG8_WAIT_L(0); PG8_MMA(1, 0, At, B0); PG8_BAR; PG8_SCHED;
            PG8_STAGE(PG8_SB(1, 1), b3 + hstepB, voffB);
            PG8_WAIT_V(6); PG8_BAR; PG8_MMA(1, 1, At, B1); PG8_BAR;
            }
        }
        if constexpr (ALIGN_EPI) { if (wr == 0) PG8_BAR; }
        { int l2; asm volatile("v_mbcnt_lo_u32_b32 %0, -1, 0\n\tv_mbcnt_hi_u32_b32 %0, -1, %0" : "=v"(l2)); E(acc, cur, wr, wc, l2 & 15, l2 >> 4); }
        if (!has_next) break;
#pragma unroll
        for (int a = 0; a < 2; ++a)
#pragma unroll
            for (int b = 0; b < 2; ++b)
#pragma unroll
                for (int m = 0; m < 4; ++m)
#pragma unroll
                    for (int n = 0; n < 2; ++n) acc[a][b][m][n] = (f32x4){0.f, 0.f, 0.f, 0.f};
        cur = nxt; cA = nA; cB = nB; ++ui;
        if constexpr (ALIGN_EPI) { if (wr == 1) PG8_BAR; }
    }
    PG8_WAIT_V(0);
    if constexpr (!ALIGN_EPI) { if (wr == 0) PG8_BAR; }
    PG8_BAR;
#undef PG8_SA
#undef PG8_SB
#undef PG8_STAGE
#undef PG8_LDA
#undef PG8_LDB
#undef PG8_MMA
#undef PG8_WAIT_V
#undef PG8_WAIT_L
#undef PG8_BAR
#undef PG8_SCHED
}
}
namespace att {
using bf16x8 = __attribute__((ext_vector_type(8))) short;
using s16x4  = __attribute__((ext_vector_type(4))) short;
using f32x16 = __attribute__((ext_vector_type(16))) float;
using f32x4v = __attribute__((ext_vector_type(4))) float;
using u32x4  = __attribute__((ext_vector_type(4))) unsigned;
typedef unsigned short bf16_t;
constexpr int NW = 8, QBLK = 32, KVBLK = 64;
constexpr int LDQ = 3072, LDKV = 4096, LDKR = 64, LDO = 2048;
constexpr float SCALE = 0.07216878364870322f;
constexpr float THR = 8.f;
constexpr int SDEPTH = 1;
constexpr int SHM_V = KVBLK * 128 * 2, SHM_KN = KVBLK * 128 * 2, SHM_KR = KVBLK * 64 * 2;
constexpr int OFF_V = 0, OFF_KN = 2 * SHM_V, OFF_KR = OFF_KN + 2 * SHM_KN, OFF_WS = OFF_KR + 2 * SHM_KR, OFF_QR = OFF_WS + NW * 64 * 4, LDS_BYTES = OFF_QR + NW * 4096;
#define KSWZ(row, colB) ((row) * 256 + ((colB) ^ (((row) & 15) << 4)))
#define KRSWZ(row, colB) ((row) * 128 + ((colB) ^ ((((row) >> 1) & 7) << 4)))
#define SBAR() __builtin_amdgcn_sched_barrier(0)
__device__ __forceinline__ int crow(int r, int hi) { return (r & 3) + 8 * (r >> 2) + 4 * hi; }
__device__ __forceinline__ unsigned cvtpk(float lo, float hi) { unsigned r; asm volatile("v_cvt_pk_bf16_f32 %0, %1, %2" : "=v"(r) : "v"(lo), "v"(hi)); return r; }
__device__ __forceinline__ float bf2f(unsigned short b) { return __uint_as_float((unsigned)b << 16); }

constexpr float THRL = THR * 1.4426950408889634f;
template <bool FIRST> __device__ __forceinline__ void partialSM(f32x16& p0, f32x16& p1, float& mhat, f32x16& negm, float& alpha) {
  float pmax = p0[0];
#pragma unroll
  for (int r = 1; r < 16; ++r) pmax = fmaxf(pmax, p0[r]);
#pragma unroll
  for (int r = 0; r < 16; ++r) pmax = fmaxf(pmax, p1[r]);
  { auto rr = __builtin_amdgcn_permlane32_swap(__float_as_uint(pmax), __float_as_uint(pmax), false, false);
    pmax = fmaxf(__uint_as_float(rr[0]), __uint_as_float(rr[1])); }
  alpha = 1.f;
  if (FIRST || !__builtin_expect(__all(pmax <= THRL), 1)) {
    const float dl = FIRST ? pmax : fmaxf(pmax, 0.f); mhat += dl;
#pragma unroll
    for (int r = 0; r < 16; ++r) { p0[r] -= dl; p1[r] -= dl; }
#pragma unroll
    for (int r = 0; r < 16; ++r) negm[r] = -mhat;
    if (!FIRST) alpha = __builtin_amdgcn_exp2f(-dl);
  }
#pragma unroll
  for (int r = 0; r < 16; ++r) p0[r] = __builtin_amdgcn_exp2f(p0[r]);
}
__device__ __forceinline__ void finishSM(f32x16& p0, f32x16& p1, float alpha, float& l_reg, bf16x8& pa0, bf16x8& pa1, bf16x8& pa2, bf16x8& pa3) {
#pragma unroll
  for (int r = 0; r < 16; ++r) p1[r] = __builtin_amdgcn_exp2f(p1[r]);
  float ps = 0;
#pragma unroll
  for (int r = 0; r < 16; ++r) ps += p0[r];
#pragma unroll
  for (int r = 0; r < 16; ++r) ps += p1[r];
  { auto rr = __builtin_amdgcn_permlane32_swap(__float_as_uint(ps), __float_as_uint(ps), false, false);
    ps = __uint_as_float(rr[0]) + __uint_as_float(rr[1]); }
  l_reg = l_reg * alpha + ps;
#define PK4(P, BASE, OUT) do { unsigned a0 = cvtpk(P[BASE + 0], P[BASE + 1]), a1 = cvtpk(P[BASE + 2], P[BASE + 3]);   \
    unsigned b0 = cvtpk(P[BASE + 4], P[BASE + 5]), b1 = cvtpk(P[BASE + 6], P[BASE + 7]);                              \
    auto r0 = __builtin_amdgcn_permlane32_swap(a0, b0, false, false); auto r1 = __builtin_amdgcn_permlane32_swap(a1, b1, false, false); \
    u32x4 w = {r0[0], r1[0], r0[1], r1[1]}; OUT = *reinterpret_cast<bf16x8*>(&w); } while (0)
  PK4(p0, 0, pa0); PK4(p0, 8, pa1); PK4(p1, 0, pa2); PK4(p1, 8, pa3);
#undef PK4
}
__device__ __forceinline__ void qkt(f32x16& p0, f32x16& p1, const char* Kn, const char* Kr, const bf16x8* qr, const char* qrl, const f32x16& negm, int r32, int hi) {
  p0 = negm; p1 = negm;
#pragma unroll
  for (int d0 = 0; d0 < 8; ++d0) { const int cb = (d0 * 16 + hi * 8) * 2;
    bf16x8 b0 = *reinterpret_cast<const bf16x8*>(Kn + KSWZ(r32, cb));
    bf16x8 b1 = *reinterpret_cast<const bf16x8*>(Kn + KSWZ(32 + r32, cb));
    p0 = __builtin_amdgcn_mfma_f32_32x32x16_bf16(b0, qr[d0], p0, 0, 0, 0);
    p1 = __builtin_amdgcn_mfma_f32_32x32x16_bf16(b1, qr[d0], p1, 0, 0, 0); }
#pragma unroll
  for (int d0 = 0; d0 < 4; ++d0) { const int cb = (d0 * 16 + hi * 8) * 2;
    bf16x8 b0 = *reinterpret_cast<const bf16x8*>(Kr + KRSWZ(r32, cb));
    bf16x8 b1 = *reinterpret_cast<const bf16x8*>(Kr + KRSWZ(32 + r32, cb));
    const bf16x8 qv = *reinterpret_cast<const bf16x8*>(qrl + d0 * 1024);
    p0 = __builtin_amdgcn_mfma_f32_32x32x16_bf16(b0, qv, p0, 0, 0, 0);
    p1 = __builtin_amdgcn_mfma_f32_32x32x16_bf16(b1, qv, p1, 0, 0, 0); }
}
__device__ __forceinline__ int v_st(int k, int c) { const int kk = (k & ~0xC) | ((k & 4) << 1) | ((k & 8) >> 1); return ((kk >> 3) * 4 + (c >> 5)) * 512 + ((kk & 7) * 32 + (c & 31)) * 2; }
__device__ __forceinline__ int v_rd_base(int lane) { return ((lane & 3) << 3) | (((lane >> 2) & 3) << 6) | (((lane >> 4) & 1) << 5) | (((lane >> 5) & 1) << 8); }
constexpr int v_rd_off(int d0, int ks, int half) { return d0 * 512 + ks * 4096 + half * 2048; }
template <int OFF> __device__ __forceinline__ s16x4 tr_read(int vb) {
  s16x4 r; asm volatile("ds_read_b64_tr_b16 %0, %1 offset:%2" : "=&v"(r) : "v"(vb), "i"(OFF) : "memory"); return r;
}
template <int D0> __device__ __forceinline__ void pv_one(f32x16& od, int vb, bf16x8 pa0, bf16x8 pa1, bf16x8 pa2, bf16x8 pa3) {
  const s16x4 l0 = tr_read<v_rd_off(D0, 0, 0)>(vb), h0 = tr_read<v_rd_off(D0, 0, 1)>(vb), l1 = tr_read<v_rd_off(D0, 1, 0)>(vb), h1 = tr_read<v_rd_off(D0, 1, 1)>(vb);
  const s16x4 l2 = tr_read<v_rd_off(D0, 2, 0)>(vb), h2 = tr_read<v_rd_off(D0, 2, 1)>(vb), l3 = tr_read<v_rd_off(D0, 3, 0)>(vb), h3 = tr_read<v_rd_off(D0, 3, 1)>(vb);
  asm volatile("s_waitcnt lgkmcnt(0)" ::: "memory"); SBAR();
#define PK(L, H) (bf16x8){L[0], L[1], L[2], L[3], H[0], H[1], H[2], H[3]}
  od = __builtin_amdgcn_mfma_f32_32x32x16_bf16(pa0, PK(l0, h0), od, 0, 0, 0);
  od = __builtin_amdgcn_mfma_f32_32x32x16_bf16(pa1, PK(l1, h1), od, 0, 0, 0);
  od = __builtin_amdgcn_mfma_f32_32x32x16_bf16(pa2, PK(l2, h2), od, 0, 0, 0);
  od = __builtin_amdgcn_mfma_f32_32x32x16_bf16(pa3, PK(l3, h3), od, 0, 0, 0);
#undef PK
}
__device__ __forceinline__ void pv_d0(f32x16* o, int vb, bf16x8 pa0, bf16x8 pa1, bf16x8 pa2, bf16x8 pa3) {
  pv_one<0>(o[0], vb, pa0, pa1, pa2, pa3); pv_one<1>(o[1], vb, pa0, pa1, pa2, pa3); pv_one<2>(o[2], vb, pa0, pa1, pa2, pa3); pv_one<3>(o[3], vb, pa0, pa1, pa2, pa3);
}

constexpr int RK = 3 * (SHM_KN + SHM_KR), RV = 3 * SHM_V;
constexpr int D_OFF_K = 0, D_OFF_V = RK, D_OFF_WS = RK + RV, D_OFF_QR = D_OFF_WS + NW * 64 * 4  , D_LDS_BYTES = D_OFF_QR + NW * 4096;
__device__ __forceinline__ void attn_unit(const bf16_t* __restrict__ Qb, const bf16_t* __restrict__ Kn, const bf16_t* __restrict__ Vh, const bf16_t* __restrict__ Kr,
                                          bf16_t* __restrict__ Ob, const float* __restrict__ rope, int pos0, int seq, char* lds, int wid  ) {
  typedef __attribute__((address_space(3))) unsigned las_u32;
  int lane; asm volatile("v_mbcnt_lo_u32_b32 %0, -1, 0\n\tv_mbcnt_hi_u32_b32 %0, -1, %0" : "=v"(lane));
  const int r32 = lane & 31, hi = lane >> 5;
  float* ws = (float*)(lds + D_OFF_WS) + wid * 64; float* li_l = ws; float* al_l = ws + 32;
  float mhat = 0.f, l_reg = 0; f32x16 o[4] = {}; bf16x8 qr[12]; f32x16 negm = f32x16{};
  constexpr float CQ = SCALE * 1.4426950408889634f;
  const bf16_t* Qw = Qb + (long)(wid * QBLK + r32) * LDQ + hi * 8;
#pragma unroll
  for (int d0 = 0; d0 < 12; ++d0) qr[d0] = *reinterpret_cast<const bf16x8*>(Qw + d0 * 16);
#pragma unroll
  for (int d0 = 0; d0 < 12; ++d0) if (d0 < 8 || !rope) { bf16x8 q = qr[d0]; u32x4 w;
    w.x = cvtpk(bf2f((unsigned short)q[0]) * CQ, bf2f((unsigned short)q[1]) * CQ); w.y = cvtpk(bf2f((unsigned short)q[2]) * CQ, bf2f((unsigned short)q[3]) * CQ);
    w.z = cvtpk(bf2f((unsigned short)q[4]) * CQ, bf2f((unsigned short)q[5]) * CQ); w.w = cvtpk(bf2f((unsigned short)q[6]) * CQ, bf2f((unsigned short)q[7]) * CQ);
    qr[d0] = *reinterpret_cast<bf16x8*>(&w); }
  if (rope) {
    const float* rp = rope + (long)(pos0 + wid * QBLK + r32) * 64;
#pragma unroll
    for (int d0 = 0; d0 < 4; ++d0) {
      const int p0i = d0 * 8 + hi * 4;
      const f32x4v c0 = *reinterpret_cast<const f32x4v*>(rp + p0i * 2), c1 = *reinterpret_cast<const f32x4v*>(rp + p0i * 2 + 4);
      bf16x8 q = qr[8 + d0];
      const float a0 = bf2f((unsigned short)q[0]) * CQ, b0 = bf2f((unsigned short)q[1]) * CQ, a1 = bf2f((unsigned short)q[2]) * CQ, b1 = bf2f((unsigned short)q[3]) * CQ;
      const float a2 = bf2f((unsigned short)q[4]) * CQ, b2 = bf2f((unsigned short)q[5]) * CQ, a3 = bf2f((unsigned short)q[6]) * CQ, b3 = bf2f((unsigned short)q[7]) * CQ;
      u32x4 w;
      w.x = cvtpk(a0 * c0[0] - b0 * c0[1], b0 * c0[0] + a0 * c0[1]);
      w.y = cvtpk(a1 * c0[2] - b1 * c0[3], b1 * c0[2] + a1 * c0[3]);
      w.z = cvtpk(a2 * c1[0] - b2 * c1[1], b2 * c1[0] + a2 * c1[1]);
      w.w = cvtpk(a3 * c1[2] - b3 * c1[3], b3 * c1[2] + a3 * c1[3]);
      qr[8 + d0] = *reinterpret_cast<bf16x8*>(&w);
    }
  }
  char* qrl = lds + D_OFF_QR + wid * 4096 + lane * 16;
#pragma unroll
  for (int d0 = 0; d0 < 4; ++d0) *reinterpret_cast<bf16x8*>(qrl + d0 * 1024) = qr[8 + d0];
  unsigned gkn[2], gv[2], gkr;
#pragma unroll
  for (int i = 0; i < 2; ++i) {
    const int c = 2 * wid + i;
    { const int row = 4 * c + (lane >> 4), colB = ((lane & 15) * 16) ^ ((row & 15) << 4); gkn[i] = (unsigned)(row * LDKV + (colB >> 1)) * 2u; }
    { const int sub = 2 * c + (lane >> 5), kk = (sub >> 2) * 8 + ((lane & 31) >> 2), key = (kk & ~0xC) | ((kk & 4) << 1) | ((kk & 8) >> 1), col = (sub & 3) * 32 + (lane & 3) * 8; gv[i] = (unsigned)(key * LDKV + col) * 2u; }
  }
  { const int row = 8 * wid + (lane >> 3), colB = ((lane & 7) * 16) ^ (((row >> 1) & 7) << 4); gkr = (unsigned)(row * LDKR + (colB >> 1)) * 2u; }
  char* Kring = lds + D_OFF_K; char* Vring = lds + D_OFF_V;
#define DMA16(gp, lp) __builtin_amdgcn_global_load_lds((const unsigned*)(gp), (las_u32*)(lp), 16, 0, 0)
#define ISSUE_K(t, slot) do { const bf16_t* kb_ = Kn + (long)(t) * KVBLK * LDKV; const bf16_t* rb_ = Kr + (long)(t) * KVBLK * LDKR; asm volatile("" : "+s"(kb_), "+s"(rb_)); char* d_ = Kring + (slot) * (SHM_KN + SHM_KR); \
    asm volatile("" : "+v"(gkn[0]), "+v"(gkn[1]), "+v"(gkr));     \
    DMA16((const char*)kb_ + gkn[0], d_ + (2 * wid) * 1024); DMA16((const char*)kb_ + gkn[1], d_ + (2 * wid + 1) * 1024); DMA16((const char*)rb_ + gkr, d_ + SHM_KN + wid * 1024); } while (0)
#define ISSUE_V(t, slot) do { const bf16_t* vb_ = Vh + (long)(t) * KVBLK * LDKV; asm volatile("" : "+s"(vb_)); char* d_ = Vring + (slot) * SHM_V; \
    asm volatile("" : "+v"(gv[0]), "+v"(gv[1])); \
    DMA16((const char*)vb_ + gv[0], d_ + (2 * wid) * 1024); DMA16((const char*)vb_ + gv[1], d_ + (2 * wid + 1) * 1024); } while (0)
#define WAITV(n) asm volatile("s_waitcnt vmcnt(" #n ")" ::: "memory")
#define BARRIER() do { asm volatile("" ::: "memory"); __builtin_amdgcn_s_barrier(); asm volatile("" ::: "memory"); } while (0)
#define RESC(a) do { if (__any((a) < 1.f)) { if (hi == 0) al_l[r32] = (a); asm volatile("s_waitcnt lgkmcnt(0)" ::: "memory"); \
    _Pragma("unroll") for (int d = 0; d < 4; ++d) _Pragma("unroll") for (int r = 0; r < 16; ++r) o[d][r] *= al_l[crow(r, hi)]; } } while (0)
  const int vb0 = (int)(uintptr_t)Vring + v_rd_base(lane);
  f32x16 pA0, pA1, pB0, pB1; float alA, alB; bf16x8 pa0, pa1, pa2, pa3; const int NT = seq / KVBLK;
  int s_cur = 0, s_nxt = 1, s_prv = 2;
#define ROT() do { const int t_ = s_prv; s_prv = s_cur; s_cur = s_nxt; s_nxt = t_; } while (0)
  if (wid >= 4) __builtin_amdgcn_s_setprio(1);
  WAITV(0);
  ISSUE_K(0, 0);
  ISSUE_K(1, 1); ISSUE_V(0, 0);
  WAITV(5); BARRIER();
  if (2 < NT) ISSUE_K(2, 2);
  ISSUE_V(1, 1);
  qkt(pA0, pA1, Kring, Kring + SHM_KN, qr, qrl, negm, r32, hi); partialSM<true>(pA0, pA1, mhat, negm, alA);
  ROT();
  for (int j = 1; j + 1 < NT; j += 2) {
    WAITV(5); BARRIER();
    if (j + 2 < NT) ISSUE_K(j + 2, s_prv);
    ISSUE_V(j + 1, s_nxt);
    SBAR(); qkt(pB0, pB1, Kring + s_cur * (SHM_KN + SHM_KR), Kring + s_cur * (SHM_KN + SHM_KR) + SHM_KN, qr, qrl, negm, r32, hi);
    finishSM(pA0, pA1, alA, l_reg, pa0, pa1, pa2, pa3); SBAR();
    pv_d0(o, vb0 + s_prv * SHM_V, pa0, pa1, pa2, pa3); partialSM<false>(pB0, pB1, mhat, negm, alB);
    RESC(alB);
    ROT();
    WAITV(5); BARRIER();
    if (j + 3 < NT) ISSUE_K(j + 3, s_prv);
    ISSUE_V(j + 2, s_nxt);
    SBAR(); qkt(pA0, pA1, Kring + s_cur * (SHM_KN + SHM_KR), Kring + s_cur * (SHM_KN + SHM_KR) + SHM_KN, qr, qrl, negm, r32, hi);
    finishSM(pB0, pB1, alB, l_reg, pa0, pa1, pa2, pa3); SBAR();
    pv_d0(o, vb0 + s_prv * SHM_V, pa0, pa1, pa2, pa3); partialSM<false>(pA0, pA1, mhat, negm, alA);
    RESC(alA);
    ROT();
  }
  WAITV(2); BARRIER();
  SBAR(); qkt(pB0, pB1, Kring + s_cur * (SHM_KN + SHM_KR), Kring + s_cur * (SHM_KN + SHM_KR) + SHM_KN, qr, qrl, negm, r32, hi);
  finishSM(pA0, pA1, alA, l_reg, pa0, pa1, pa2, pa3); SBAR();
  pv_d0(o, vb0 + s_prv * SHM_V, pa0, pa1, pa2, pa3); partialSM<false>(pB0, pB1, mhat, negm, alB);
  RESC(alB);
  WAITV(0); BARRIER();
  finishSM(pB0, pB1, alB, l_reg, pa0, pa1, pa2, pa3); SBAR();
  pv_d0(o, vb0 + s_cur * SHM_V, pa0, pa1, pa2, pa3);
  __builtin_amdgcn_s_setprio(0);
  if (hi == 0) li_l[r32] = l_reg; asm volatile("s_waitcnt lgkmcnt(0)" ::: "memory");
  float rli[16];
#pragma unroll
  for (int r = 0; r < 16; ++r) rli[r] = __builtin_amdgcn_rcpf(li_l[crow(r, hi)]);
  bf16_t* Ow = Ob + (long)(wid * QBLK) * LDO;
#pragma unroll
  for (int r = 0; r < 16; ++r) { const int orow = crow(r, hi);
#pragma unroll
    for (int d0 = 0; d0 < 4; ++d0) { const float v = o[d0][r] * rli[r]; Ow[(long)orow * LDO + d0 * 32 + r32] = (bf16_t)(cvtpk(v, v) & 0xffffu); } }
  asm volatile("s_waitcnt lgkmcnt(0)" ::: "memory"); BARRIER();
#undef DMA16
#undef ISSUE_K
#undef ISSUE_V
#undef WAITV
#undef BARRIER
#undef RESC
#undef ROT
}
#undef KSWZ
#undef KRSWZ
#undef SBAR
}
constexpr int NWAVES = 8;
constexpr int DM = 2048, SEQ = 8192, CTXL = 256, T = SEQ + CTXL  , DEPTH = 4;
constexpr int NH = 16, QL = 512, KVL = 512, DNOPE = 128, DROPE = 64, DV = 128;
constexpr int NDQ = QL + KVL + DROPE  , NDQP = 1280  , NUQ = NH * (DNOPE + DROPE)  , NUKV = NH * (DNOPE + DV)  ;
constexpr int DFF = 5632, NUP = 2 * DFF  ;
constexpr int NMOD = 6;
constexpr float NORM_EPS = 1e-6f;
constexpr int GC = 256  , NG = 8;

constexpr size_t MiB = 1u << 20;
constexpr size_t WS_CTL = 0, CTL_ZERO_BYTES = 1 * MiB;
constexpr size_t WS_MOD = 1 * MiB;
constexpr size_t WS_ROPE = 2 * MiB;
constexpr size_t WS_WCT = 4 * MiB;
constexpr size_t WS_WCT4 = 6 * MiB;
constexpr size_t WS_DSC = 5 * MiB;
constexpr size_t WS_WDQ = 8 * MiB;
constexpr size_t WS_WUQ = 18 * MiB;
constexpr size_t WS_WUKV = 24 * MiB;
constexpr size_t WS_WO = 32 * MiB;
constexpr size_t WS_WFNO = 48 * MiB;
constexpr size_t WS_WUP = 64 * MiB;
constexpr size_t WS_WDN = 240 * MiB;
constexpr size_t WS_DS = 384 * MiB;
constexpr size_t WS_XS = 640 * MiB;
constexpr size_t WS_HN = 720 * MiB;
constexpr size_t WS_SSQ = 760 * MiB;
constexpr size_t WS_CQN = 808 * MiB;
constexpr size_t WS_CKVN = 820 * MiB;
constexpr size_t WS_KR = 832 * MiB;
constexpr size_t WS_Q = 840 * MiB;
constexpr size_t WS_KV = 896 * MiB;
constexpr size_t WS_O = 968 * MiB;
constexpr size_t WS_U = 1008 * MiB;
constexpr size_t WS_ACT = 1192 * MiB;
constexpr size_t WS_YT = 1288 * MiB;
constexpr size_t WS_YTC = 1352 * MiB;
constexpr size_t WS_PART = 1356 * MiB;
constexpr size_t WS_PQ = 1380 * MiB;
constexpr size_t WS_H4 = 1412 * MiB;
constexpr size_t WS_V1 = 1413 * MiB;
constexpr size_t WS_U2C = 1414 * MiB;
constexpr size_t WS_EDGE = 330 * MiB;
constexpr size_t WS_CWS = 338 * MiB;
constexpr size_t WS_END = 1430 * MiB;
constexpr int CW_BAR = 4096;

constexpr int RING_OFF = 0, RING_BYTES = 131072;
constexpr int XCH_OFF = 131072;
constexpr int LDSCTL_OFF = 158720, MISC_OFF = LDSCTL_OFF + 320;
constexpr int LDS_BYTES = 163840;

#define GAS __attribute__((address_space(1)))
#define LAS __attribute__((address_space(3)))
typedef unsigned short bf16;
typedef unsigned v4u __attribute__((ext_vector_type(4)));
typedef unsigned v2u __attribute__((ext_vector_type(2)));
typedef float f32x4 __attribute__((ext_vector_type(4)));
typedef GAS unsigned gu32;
#define LDS_WAIT() asm volatile("s_waitcnt lgkmcnt(0)" ::: "memory")
#define VM_WAIT() asm volatile("s_waitcnt vmcnt(0)" ::: "memory")
__device__ __forceinline__ unsigned f2bf(float f) { unsigned u = __builtin_bit_cast(unsigned, f); return (u + 0x7fffu + ((u >> 16) & 1u)) >> 16; }
__device__ __forceinline__ unsigned pk2(float lo, float hi) { return f2bf(lo) | (f2bf(hi) << 16); }
__device__ __forceinline__ float bflo(unsigned w) { return __uint_as_float(w << 16); }
__device__ __forceinline__ float bfhi(unsigned w) { return __uint_as_float(w & 0xffff0000u); }
__device__ __forceinline__ float silu_f(float v) { return v / (1.f + __expf(-v)); }

#define XB_TMO      128
#define XB_XCNT(j)  (256  + 64 * (j))
#define XB_XSUB(j)  (1280 + 64 * (j))
#define XB_XGEN(j)  (2304 + 64 * (j))
#define XB_TOP      3328
#define XB_TOPGEN   3392
#define XCD_BAR_WORDS 3456
#define XB_SPIN_CAP (1u << 18)
__device__ __forceinline__ unsigned xb_ld(unsigned* p)              { return __hip_atomic_load(p, __ATOMIC_RELAXED, __HIP_MEMORY_SCOPE_AGENT); }
__device__ __forceinline__ unsigned xb_add(unsigned* p, unsigned v) { return __hip_atomic_fetch_add(p, v, __ATOMIC_RELAXED, __HIP_MEMORY_SCOPE_AGENT); }
__device__ __forceinline__ unsigned xb_xcc_id() { return (unsigned)__builtin_amdgcn_s_getreg((3 << 11) | 20) & 0xFu; }
#define XB_SPIN(cond, bar) do { unsigned _sp = 0; while (cond) { __builtin_amdgcn_s_sleep(1); \
    if ((++_sp & 255u) == 0u) { if (xb_ld(&(bar)[XB_TMO])) break; if (_sp > XB_SPIN_CAP) { atomicAdd(&(bar)[XB_TMO], 1u); break; } } } } while (0)
struct XcdBarrier { unsigned* bar; unsigned x; volatile LAS unsigned* st; };
__device__ __forceinline__ XcdBarrier xcd_barrier_post(unsigned* bar, volatile LAS unsigned* st) {
    XcdBarrier b; b.bar = bar; b.x = xb_xcc_id(); b.st = st;
    if (threadIdx.x == 0) (void)xb_add(&bar[XB_XCNT(b.x)], 1u);
    return b;
}
__device__ __forceinline__ void xcd_barrier_complete(unsigned* bar, unsigned x, unsigned& nloc, unsigned& nx) {
    const unsigned G = gridDim.x * gridDim.y * gridDim.z;
    unsigned sum, cnt, mine, sp = 0u;
    for (;;) {
        sum = 0u; cnt = 0u; mine = 0u;
#pragma unroll
        for (unsigned j = 0; j < 16; ++j) { const unsigned c = xb_ld(&bar[XB_XCNT(j)]); sum += c; cnt += (c > 0u) ? 1u : 0u; mine = (j == x) ? c : mine; }
        if (sum == G) break;
        __builtin_amdgcn_s_sleep(1);
        if ((++sp & 255u) == 0u) { if (xb_ld(&bar[XB_TMO])) break; if (sp > XB_SPIN_CAP) { atomicAdd(&bar[XB_TMO], 1u); break; } }
    }
    nloc = mine > 0u ? mine : 1u; nx = cnt > 0u ? cnt : 1u;
}
__device__ __forceinline__ void xcd_barrier(const XcdBarrier& b) {
    asm volatile("s_waitcnt vmcnt(0)" ::: "memory");
    __syncthreads();
    if (threadIdx.x == 0) {
        unsigned* bar = b.bar; unsigned bx_ = b.x; asm volatile("" : "+s"(bar), "+s"(bx_));
        __builtin_amdgcn_s_waitcnt(0);
        unsigned nloc = b.st[0], nx = b.st[1];
        if (nloc == 0u) { xcd_barrier_complete(bar, bx_, nloc, nx); b.st[0] = nloc; b.st[1] = nx; }
        const unsigned old = xb_add(&bar[XB_XSUB(bx_)], 1u);
        const unsigned gen = old / nloc;
        if (old + 1u == (gen + 1u) * nloc) {
            __builtin_amdgcn_fence(__ATOMIC_RELEASE, "agent");
            asm volatile("s_waitcnt vmcnt(0)" ::: "memory");
            const unsigned og = xb_add(&bar[XB_TOP], 1u);
            const unsigned tg = og / nx;
            if (og + 1u == (tg + 1u) * nx) xb_add(&bar[XB_TOPGEN], 1u);
            else XB_SPIN(xb_ld(&bar[XB_TOPGEN]) == tg, bar);
            __builtin_amdgcn_fence(__ATOMIC_ACQUIRE, "agent");
            xb_add(&bar[XB_XGEN(bx_)], 1u);
            asm volatile("s_waitcnt vmcnt(0)" ::: "memory");
        } else {
            XB_SPIN(xb_ld(&bar[XB_XGEN(bx_)]) == gen, bar);
            __builtin_amdgcn_fence(__ATOMIC_ACQUIRE, "agent");
            asm volatile("s_waitcnt vmcnt(0)" ::: "memory");
        }
    }
    __syncthreads();
}

__device__ __forceinline__ int lane_id_opaque() { int lane; asm volatile("v_mbcnt_lo_u32_b32 %0, -1, 0\n\tv_mbcnt_hi_u32_b32 %0, -1, %0" : "=v"(lane)); return lane; }
__device__ __forceinline__ float wave_sum(float v, int lane) {
#pragma unroll
    for (int o = 1; o < 64; o <<= 1) v += __builtin_bit_cast(float, __builtin_amdgcn_ds_bpermute((lane ^ o) << 2, __builtin_bit_cast(int, v)));
    return v;
}

template <int MODE> __device__ __forceinline__ int dest_row(int n) {
    if (MODE == 1) {
        const int h = n / 192, c = n - h * 192; if (c < 128) return n;
        const int e = c - 128, half = e >> 5, second = (e >> 4) & 1, j = e & 15; return h * 192 + 128 + 2 * (half * 16 + j) + second;
    } else if (MODE == 2) {
        const int g = n >= DFF ? 1 : 0, c = n - g * DFF, t = c >> 7, i = c & 127; return t * 256 + g * 128 + i;
    } else if (MODE == 3) {
        if (n < QL + KVL) return n;
        const int e = n - (QL + KVL), half = e >> 5, second = (e >> 4) & 1, j = e & 15; return QL + KVL + 2 * (half * 16 + j) + second;
    }
    return n;
}
template <int MODE> __device__ __forceinline__ void p0_transpose_item(const float* W, int K, int N, bf16* WT, LAS float* scr, int item, int lane, const float* ks = nullptr) {
    const int nblk = N / 32, i8 = item >> 3, kb = (i8 / nblk) * 8 + (item & 7), nb = i8 % nblk, k0 = 64 * kb, n0 = 32 * nb;
    { f32x4 w[8]; const int c4 = (lane & 7) * 4;
#pragma unroll
      for (int i = 0; i < 8; ++i) w[i] = *(const GAS f32x4*)(W + (size_t)(k0 + 8 * i + (lane >> 3)) * N + n0 + c4);
#pragma unroll
      for (int i = 0; i < 8; ++i) { LAS float* d = scr + (8 * i + (lane >> 3)) * 33 + c4; d[0] = w[i].x; d[1] = w[i].y; d[2] = w[i].z; d[3] = w[i].w; } }
    LDS_WAIT(); asm volatile("" ::: "memory");
    const int c = lane & 7;
    float kq[8];
#pragma unroll
    for (int i = 0; i < 8; ++i) kq[i] = ks ? ks[k0 + 8 * c + i] : 1.0f;
#pragma unroll
    for (int j = 0; j < 4; ++j) { const int n = (lane >> 3) + 8 * j; const LAS float* s = scr + (8 * c) * 33 + n;
        v4u o; o.x = pk2(s[0 * 33] * kq[0], s[1 * 33] * kq[1]); o.y = pk2(s[2 * 33] * kq[2], s[3 * 33] * kq[3]); o.z = pk2(s[4 * 33] * kq[4], s[5 * 33] * kq[5]); o.w = pk2(s[6 * 33] * kq[6], s[7 * 33] * kq[7]);
        *(GAS v4u*)(WT + (size_t)dest_row<MODE>(n0 + n) * K + k0 + 8 * c) = o; }
    LDS_WAIT(); asm volatile("" ::: "memory");
}
__device__ __forceinline__ void unpack8(const v4u w, float (&f)[8]) {
#pragma unroll
    for (int e = 0; e < 4; ++e) { f[2 * e] = bflo(w[e]); f[2 * e + 1] = bfhi(w[e]); }
}
__device__ __forceinline__ v4u pack8(const float (&f)[8]) { v4u w; w.x = pk2(f[0], f[1]); w.y = pk2(f[2], f[3]); w.z = pk2(f[4], f[5]); w.w = pk2(f[6], f[7]); return w; }
__device__ __forceinline__ void norm_rows(int gw, int NGW, int row_lo, int row_hi, bf16* xs, bool xs_in, const float* xin, const float* ctxin,
                                          const float* g, const float* modx, const float* modc, int shi, int sci, bf16* HN, const float* part, int npart) {
    const int lane = lane_id_opaque(); asm volatile("" : "+s"(gw), "+s"(NGW));
    for (int row = row_lo + gw; row < row_hi; row += NGW) {
        const float* mod = row < CTXL ? modc : modx;
        float v[4][8]; float ss = 0.f; bool wb = false;
        if (xs_in) {
#pragma unroll
            for (int j = 0; j < 4; ++j) unpack8(*(const GAS v4u*)(xs + (size_t)row * DM + lane * 8 + 512 * j), v[j]);
        } else { const float* src = row < CTXL ? ctxin + (size_t)row * DM : xin + (size_t)(row - CTXL) * DM; wb = true;
#pragma unroll
            for (int j = 0; j < 4; ++j) { const f32x4 a = *(const GAS f32x4*)(src + lane * 8 + 512 * j), c = *(const GAS f32x4*)(src + lane * 8 + 512 * j + 4);
                v[j][0] = a.x; v[j][1] = a.y; v[j][2] = a.z; v[j][3] = a.w; v[j][4] = c.x; v[j][5] = c.y; v[j][6] = c.z; v[j][7] = c.w; }
        }
        if (row < CTXL && npart > 0) {
            for (int z = 0; z < npart; ++z) { const float* pr = part + ((size_t)z * CTXL + row) * DM + lane * 8;
#pragma unroll
                for (int j = 0; j < 4; ++j) { const f32x4 a = *(const GAS f32x4*)(pr + 512 * j), c = *(const GAS f32x4*)(pr + 512 * j + 4);
                    v[j][0] += a.x; v[j][1] += a.y; v[j][2] += a.z; v[j][3] += a.w; v[j][4] += c.x; v[j][5] += c.y; v[j][6] += c.z; v[j][7] += c.w; } }
            wb = true;
        }
        if (wb) {
#pragma unroll
            for (int j = 0; j < 4; ++j) *(GAS v4u*)(xs + (size_t)row * DM + lane * 8 + 512 * j) = pack8(v[j]);
        }
#pragma unroll
        for (int j = 0; j < 4; ++j)
#pragma unroll
            for (int e = 0; e < 8; ++e) ss += v[j][e] * v[j][e];
        const float rstd = 1.0f / sqrtf(wave_sum(ss, lane) * (1.f / DM) + NORM_EPS);
#pragma unroll
        for (int j = 0; j < 4; ++j) { const int c = lane * 8 + 512 * j; float gq[8], sq[8], hq[8], y[8];
            { const f32x4 a = *(const GAS f32x4*)(g + c), b_ = *(const GAS f32x4*)(g + c + 4); gq[0] = a.x; gq[1] = a.y; gq[2] = a.z; gq[3] = a.w; gq[4] = b_.x; gq[5] = b_.y; gq[6] = b_.z; gq[7] = b_.w; }
            { const f32x4 a = *(const GAS f32x4*)(mod + sci * DM + c), b_ = *(const GAS f32x4*)(mod + sci * DM + c + 4); sq[0] = a.x; sq[1] = a.y; sq[2] = a.z; sq[3] = a.w; sq[4] = b_.x; sq[5] = b_.y; sq[6] = b_.z; sq[7] = b_.w; }
            { const f32x4 a = *(const GAS f32x4*)(mod + shi * DM + c), b_ = *(const GAS f32x4*)(mod + shi * DM + c + 4); hq[0] = a.x; hq[1] = a.y; hq[2] = a.z; hq[3] = a.w; hq[4] = b_.x; hq[5] = b_.y; hq[6] = b_.z; hq[7] = b_.w; }
#pragma unroll
            for (int e = 0; e < 8; ++e) y[e] = (v[j][e] * rstd) * gq[e] * (sq[e] + 1.0f) + hq[e];
            *(GAS v4u*)(HN + (size_t)row * DM + c) = pack8(y); }
    }
}
__device__ __forceinline__ void norm_ctx_wg(int vcu, int G, int wave, LAS float* red, bf16* xs, bool xs_in, const float* ctxin, const float* g, const float* modc, int shi, int sci, bf16* HN, const float* part, int npart) {
    const int lane = lane_id_opaque(); asm volatile("" : "+s"(vcu), "+s"(G));
    for (int r = vcu; r < CTXL; r += G) {
        const int c = wave * 256 + lane * 4; float v[4];
        if (xs_in) { const v2u w = *(const GAS v2u*)(xs + (size_t)r * DM + c); v[0] = bflo(w.x); v[1] = bfhi(w.x); v[2] = bflo(w.y); v[3] = bfhi(w.y); }
        else { const f32x4 a = *(const GAS f32x4*)(ctxin + (size_t)r * DM + c); v[0] = a.x; v[1] = a.y; v[2] = a.z; v[3] = a.w; }
        { f32x4 pp[11];
#pragma unroll
          for (int z = 0; z < 11; ++z) if (z < npart) pp[z] = *(const GAS f32x4*)(part + ((size_t)z * CTXL + r) * DM + c);
#pragma unroll
          for (int z = 0; z < 11; ++z) if (z < npart) { v[0] += pp[z].x; v[1] += pp[z].y; v[2] += pp[z].z; v[3] += pp[z].w; } }
        if (!xs_in || npart > 0) { v2u w; w.x = pk2(v[0], v[1]); w.y = pk2(v[2], v[3]); *(GAS v2u*)(xs + (size_t)r * DM + c) = w; }
        const float ss = wave_sum((v[0] * v[0] + v[1] * v[1]) + (v[2] * v[2] + v[3] * v[3]), lane);
        if (lane == 0) red[wave] = ss;
        __syncthreads();
        float tot = 0.f;
#pragma unroll
        for (int w8 = 0; w8 < NWAVES; ++w8) tot += red[w8];
        const float rstd = 1.0f / sqrtf(tot * (1.f / DM) + NORM_EPS);
        const f32x4 g4 = *(const GAS f32x4*)(g + c), sc4 = *(const GAS f32x4*)(modc + sci * DM + c), sh4 = *(const GAS f32x4*)(modc + shi * DM + c);
        v2u o; o.x = pk2(v[0] * rstd * g4.x * (sc4.x + 1.f) + sh4.x, v[1] * rstd * g4.y * (sc4.y + 1.f) + sh4.y); o.y = pk2(v[2] * rstd * g4.z * (sc4.z + 1.f) + sh4.z, v[3] * rstd * g4.w * (sc4.w + 1.f) + sh4.w);
        *(GAS v2u*)(HN + (size_t)r * DM + c) = o;
        __syncthreads();
    }
}
__device__ __forceinline__ void norm_quad_rows(int gw, int NGW, const bf16* xs, const float* g, const float* modx, int shi, int sci, bf16* HQ, float* HV) {
    const int lane = lane_id_opaque(); asm volatile("" : "+s"(gw), "+s"(NGW));
    constexpr int Q4 = SEQ / 4, H2 = SEQ / 2;
    for (int n = gw; n < Q4; n += NGW) {
        const int ra = n, rb = n == 0 ? Q4 : H2 - n, rc = H2 + n, rd = n == 0 ? H2 + Q4 : SEQ - n;
        v4u raw[4][4]; float rs[4];
#pragma unroll
        for (int q = 0; q < 4; ++q) { const int r = q == 0 ? ra : q == 1 ? rb : q == 2 ? rc : rd;
#pragma unroll
            for (int j = 0; j < 4; ++j) raw[q][j] = *(const GAS v4u*)(xs + (size_t)(CTXL + r) * DM + lane * 8 + 512 * j); }
#pragma unroll
        for (int q = 0; q < 4; ++q) { float ss = 0.f;
#pragma unroll
            for (int j = 0; j < 4; ++j)
#pragma unroll
                for (int e = 0; e < 4; ++e) { const float l_ = bflo(raw[q][j][e]), h_ = bfhi(raw[q][j][e]); ss += l_ * l_ + h_ * h_; }
            rs[q] = ss; }
#pragma unroll
        for (int q = 0; q < 4; ++q)
#pragma unroll
            for (int j = 0; j < 4; ++j) asm volatile("" : "+v"(raw[q][j]));
#pragma unroll
        for (int o = 1; o < 64; o <<= 1)
#pragma unroll
            for (int q = 0; q < 4; ++q) rs[q] += __builtin_bit_cast(float, __builtin_amdgcn_ds_bpermute((lane ^ o) << 2, __builtin_bit_cast(int, rs[q])));
#pragma unroll
        for (int q = 0; q < 4; ++q) rs[q] = 1.0f / sqrtf(rs[q] * (1.f / DM) + NORM_EPS);
#pragma unroll
        for (int j = 0; j < 4; ++j) { const int c = lane * 8 + 512 * j; float gs[8], sh[8], a[8], b[8], cc[8], d[8];
            { const f32x4 g0 = *(const GAS f32x4*)(g + c), g1 = *(const GAS f32x4*)(g + c + 4), s0 = *(const GAS f32x4*)(modx + sci * DM + c), s1 = *(const GAS f32x4*)(modx + sci * DM + c + 4);
              gs[0] = g0.x * (s0.x + 1.f); gs[1] = g0.y * (s0.y + 1.f); gs[2] = g0.z * (s0.z + 1.f); gs[3] = g0.w * (s0.w + 1.f); gs[4] = g1.x * (s1.x + 1.f); gs[5] = g1.y * (s1.y + 1.f); gs[6] = g1.z * (s1.z + 1.f); gs[7] = g1.w * (s1.w + 1.f); }
            { const f32x4 h0 = *(const GAS f32x4*)(modx + shi * DM + c), h1 = *(const GAS f32x4*)(modx + shi * DM + c + 4); sh[0] = h0.x; sh[1] = h0.y; sh[2] = h0.z; sh[3] = h0.w; sh[4] = h1.x; sh[5] = h1.y; sh[6] = h1.z; sh[7] = h1.w; }
            { float y0[8], y1[8], y2[8], y3[8]; unpack8(raw[0][j], y0); unpack8(raw[1][j], y1); unpack8(raw[2][j], y2); unpack8(raw[3][j], y3);
#pragma unroll
              for (int e = 0; e < 8; ++e) { a[e] = (y0[e] * rs[0]) * gs[e] + sh[e]; b[e] = (y1[e] * rs[1]) * gs[e] + sh[e]; cc[e] = (y2[e] * rs[2]) * gs[e] + sh[e]; d[e] = (y3[e] * rs[3]) * gs[e] + sh[e]; } }
            if (n == 0) {
                const float z8[8] = {0.f, 0.f, 0.f, 0.f, 0.f, 0.f, 0.f, 0.f}; const v4u w = pack8(a), wz = pack8(z8);
                *(GAS v4u*)(HQ + (size_t)0 * Q4 * DM + c) = w; *(GAS v4u*)(HQ + (size_t)1 * Q4 * DM + c) = w; *(GAS v4u*)(HQ + (size_t)2 * Q4 * DM + c) = wz; *(GAS v4u*)(HQ + (size_t)3 * Q4 * DM + c) = wz;
                *(GAS f32x4*)(HV + c) = (f32x4){cc[0], cc[1], cc[2], cc[3]}; *(GAS f32x4*)(HV + c + 4) = (f32x4){cc[4], cc[5], cc[6], cc[7]};
                *(GAS f32x4*)(HV + DM + c) = (f32x4){b[0] + d[0], b[1] + d[1], b[2] + d[2], b[3] + d[3]}; *(GAS f32x4*)(HV + DM + c + 4) = (f32x4){b[4] + d[4], b[5] + d[5], b[6] + d[6], b[7] + d[7]};
                *(GAS f32x4*)(HV + 2 * DM + c) = (f32x4){b[0] - d[0], b[1] - d[1], b[2] - d[2], b[3] - d[3]}; *(GAS f32x4*)(HV + 2 * DM + c + 4) = (f32x4){b[4] - d[4], b[5] - d[5], b[6] - d[6], b[7] - d[7]};
            } else {
                float s0[8], s1[8], s2[8], s3[8];
#pragma unroll
                for (int e = 0; e < 8; ++e) { const float ad = a[e] + d[e], bc = b[e] + cc[e], am = a[e] - d[e], bm = b[e] - cc[e]; s0[e] = ad + bc; s1[e] = ad - bc; s2[e] = am - bm; s3[e] = am + bm; }
                *(GAS v4u*)(HQ + ((size_t)0 * Q4 + n) * DM + c) = pack8(s0); *(GAS v4u*)(HQ + ((size_t)1 * Q4 + n) * DM + c) = pack8(s1);
                *(GAS v4u*)(HQ + ((size_t)2 * Q4 + n) * DM + c) = pack8(s2); *(GAS v4u*)(HQ + ((size_t)3 * Q4 + n) * DM + c) = pack8(s3);
            }
        }
    }
}
__device__ __forceinline__ void fourier_combine_rows(int gw, int NGW, const bf16* PQ4, const float* VV, const bf16* YS, bf16* F) {
    const int lane = lane_id_opaque(); asm volatile("" : "+s"(gw), "+s"(NGW));
    const float s8k = 0.011048543456039806f; constexpr int Q4 = SEQ / 4;
    for (int j = gw; j < Q4; j += NGW) {
        const float sj = (j & 1) ? -s8k : s8k;
        v4u pe_[4], po_[4], qe_[4], qo_[4];
#pragma unroll
        for (int jj = 0; jj < 4; ++jj) { const int c = lane * 8 + 512 * jj;
            pe_[jj] = *(const GAS v4u*)(PQ4 + ((size_t)0 * Q4 + j) * DM + c); po_[jj] = *(const GAS v4u*)(PQ4 + ((size_t)1 * Q4 + j) * DM + c);
            qe_[jj] = *(const GAS v4u*)(PQ4 + ((size_t)2 * Q4 + j) * DM + c); qo_[jj] = *(const GAS v4u*)(PQ4 + ((size_t)3 * Q4 + j) * DM + c); }
#pragma unroll
        for (int jj = 0; jj < 4; ++jj) {
            const int c = lane * 8 + 512 * jj;
            const v4u pe = pe_[jj], po = po_[jj], qe = qe_[jj], qo = qo_[jj];
            float v1[8], w1[8], w2[8];
            { const f32x4 a0 = *(const GAS f32x4*)(VV + c), a1 = *(const GAS f32x4*)(VV + c + 4), b0 = *(const GAS f32x4*)(VV + DM + c), b1 = *(const GAS f32x4*)(VV + DM + c + 4), c0 = *(const GAS f32x4*)(VV + 2 * DM + c), c1 = *(const GAS f32x4*)(VV + 2 * DM + c + 4);
              v1[0] = a0.x; v1[1] = a0.y; v1[2] = a0.z; v1[3] = a0.w; v1[4] = a1.x; v1[5] = a1.y; v1[6] = a1.z; v1[7] = a1.w;
              w1[0] = b0.x; w1[1] = b0.y; w1[2] = b0.z; w1[3] = b0.w; w1[4] = b1.x; w1[5] = b1.y; w1[6] = b1.z; w1[7] = b1.w;
              w2[0] = c0.x; w2[1] = c0.y; w2[2] = c0.z; w2[3] = c0.w; w2[4] = c1.x; w2[5] = c1.y; w2[6] = c1.z; w2[7] = c1.w; }
            v4u e_lo, e_hi, o_lo, o_hi;
#pragma unroll
            for (int e = 0; e < 4; ++e) {
                const float p0 = bflo(pe[e]) + sj * w1[2 * e], p1 = bfhi(pe[e]) + sj * w1[2 * e + 1], q0 = bflo(qe[e]), q1 = bfhi(qe[e]), t0 = s8k * v1[2 * e], t1 = s8k * v1[2 * e + 1];
                e_lo[e] = pk2(p0 - q0 + t0, p1 - q1 + t1); e_hi[e] = pk2(p0 + q0 + t0, p1 + q1 + t1);
                const float r0 = bflo(po[e]), r1 = bfhi(po[e]), u0 = bflo(qo[e]) + sj * w2[2 * e], u1 = bfhi(qo[e]) + sj * w2[2 * e + 1];
                o_lo[e] = pk2(r0 - u0 - t0, r1 - u1 - t1); o_hi[e] = pk2(r0 + u0 - t0, r1 + u1 - t1);
            }
            *(GAS v4u*)(F + (size_t)(2 * j) * DM + c) = e_lo;
            if (j != 0) *(GAS v4u*)(F + (size_t)(SEQ - 2 * j) * DM + c) = e_hi;
            *(GAS v4u*)(F + (size_t)(2 * j + 1) * DM + c) = o_lo;
            *(GAS v4u*)(F + (size_t)(SEQ - 2 * j - 1) * DM + c) = o_hi;
        }
    }
    for (int ch = gw; ch < DM; ch += NGW) {
        float a = 0.f;
#pragma unroll
        for (int jj = 0; jj < 4; ++jj) { const v4u y = *(const GAS v4u*)(YS + (size_t)ch * SEQ + lane * 8 + 512 * jj);
#pragma unroll
            for (int e = 0; e < 4; ++e) a += bflo(y[e]) - bfhi(y[e]); }
        a = wave_sum(a, lane);
        if (lane == 0) F[(size_t)(SEQ / 2) * DM + ch] = (bf16)f2bf(s8k * (a + VV[DM + ch] + VV[ch]));
    }
}
__device__ __forceinline__ void final_norm_rows(int gw, int NGW, const bf16* xs, const float* g, float* out) {
    const int lane = lane_id_opaque(); asm volatile("" : "+s"(gw), "+s"(NGW));
    for (int row = gw; row < SEQ; row += NGW) {
        float v[4][8]; float ss = 0.f;
#pragma unroll
        for (int j = 0; j < 4; ++j) { unpack8(*(const GAS v4u*)(xs + (size_t)(row + CTXL) * DM + lane * 8 + 512 * j), v[j]);
#pragma unroll
            for (int e = 0; e < 8; ++e) ss += v[j][e] * v[j][e]; }
        const float rstd = 1.0f / sqrtf(wave_sum(ss, lane) * (1.f / DM) + NORM_EPS);
#pragma unroll
        for (int j = 0; j < 4; ++j) { const int c = lane * 8 + 512 * j; const f32x4 g0 = *(const GAS f32x4*)(g + c), g1 = *(const GAS f32x4*)(g + c + 4);
            *(GAS f32x4*)(out + (size_t)row * DM + c) = (f32x4){v[j][0] * rstd * g0.x, v[j][1] * rstd * g0.y, v[j][2] * rstd * g0.z, v[j][3] * rstd * g0.w};
            *(GAS f32x4*)(out + (size_t)row * DM + c + 4) = (f32x4){v[j][4] * rstd * g1.x, v[j][5] * rstd * g1.y, v[j][6] * rstd * g1.z, v[j][7] * rstd * g1.w}; }
    }
}
__device__ __forceinline__ void conv_tail_rows(int gw, int NGW, const bf16* U, const bf16* U2, const float* cw, const float* cb, bf16* ACT) {
    const int lane = lane_id_opaque(); asm volatile("" : "+s"(gw), "+s"(NGW));
    constexpr int SR = 4;
    for (int it = gw; it < SEQ / SR; it += NGW) {
        const int R0 = CTXL + it * SR, c = 10 * 512 + lane * 8, ucol = (c >> 7) * 256 + (c & 127);
        v4u rv[SR + 2], rg[SR + 2], av[SR + 2], ag[SR + 2];
#pragma unroll
        for (int q = 0; q < SR + 2; ++q) { int row = R0 - 1 + q; row = row < CTXL ? CTXL : (row >= T ? T - 1 : row);
            const bf16* up = U + (size_t)row * NUP + ucol; const bf16* u2 = U2 + (size_t)(row - CTXL) * 1024 + (ucol - 40 * 256);
            rv[q] = *(const GAS v4u*)(up); rg[q] = *(const GAS v4u*)(up + 128); av[q] = *(const GAS v4u*)(u2); ag[q] = *(const GAS v4u*)(u2 + 128); }
        float wv[3][8], wg[3][8], bv[8], bg[8];
#pragma unroll
        for (int tp = 0; tp < 3; ++tp) { const f32x4 a0 = *(const GAS f32x4*)(cw + (size_t)tp * NUP + c), a1 = *(const GAS f32x4*)(cw + (size_t)tp * NUP + c + 4), g0 = *(const GAS f32x4*)(cw + (size_t)tp * NUP + DFF + c), g1 = *(const GAS f32x4*)(cw + (size_t)tp * NUP + DFF + c + 4);
            wv[tp][0] = a0.x; wv[tp][1] = a0.y; wv[tp][2] = a0.z; wv[tp][3] = a0.w; wv[tp][4] = a1.x; wv[tp][5] = a1.y; wv[tp][6] = a1.z; wv[tp][7] = a1.w;
            wg[tp][0] = g0.x; wg[tp][1] = g0.y; wg[tp][2] = g0.z; wg[tp][3] = g0.w; wg[tp][4] = g1.x; wg[tp][5] = g1.y; wg[tp][6] = g1.z; wg[tp][7] = g1.w; }
        { const f32x4 a0 = *(const GAS f32x4*)(cb + c), a1 = *(const GAS f32x4*)(cb + c + 4), g0 = *(const GAS f32x4*)(cb + DFF + c), g1 = *(const GAS f32x4*)(cb + DFF + c + 4);
            bv[0] = a0.x; bv[1] = a0.y; bv[2] = a0.z; bv[3] = a0.w; bv[4] = a1.x; bv[5] = a1.y; bv[6] = a1.z; bv[7] = a1.w;
            bg[0] = g0.x; bg[1] = g0.y; bg[2] = g0.z; bg[3] = g0.w; bg[4] = g1.x; bg[5] = g1.y; bg[6] = g1.z; bg[7] = g1.w; }
        const float z0 = (R0 == CTXL) ? 0.f : 1.f, z5 = (R0 + SR == T) ? 0.f : 1.f;
        float pv[8], pg[8], cv[8], cg[8];
        { float a[8], b[8]; unpack8(rv[0], a); unpack8(av[0], b);
#pragma unroll
          for (int e = 0; e < 8; ++e) pv[e] = (a[e] + b[e]) * z0;
          unpack8(rg[0], a); unpack8(ag[0], b);
#pragma unroll
          for (int e = 0; e < 8; ++e) pg[e] = (a[e] + b[e]) * z0;
          unpack8(rv[1], a); unpack8(av[1], b);
#pragma unroll
          for (int e = 0; e < 8; ++e) cv[e] = a[e] + b[e];
          unpack8(rg[1], a); unpack8(ag[1], b);
#pragma unroll
          for (int e = 0; e < 8; ++e) cg[e] = a[e] + b[e]; }
#pragma unroll
        for (int rr = 0; rr < SR; ++rr) {
            float nv[8], ng[8], o[8]; const float zn = (rr == SR - 1) ? z5 : 1.f;
            { float a[8], b[8]; unpack8(rv[rr + 2], a); unpack8(av[rr + 2], b);
#pragma unroll
              for (int e = 0; e < 8; ++e) nv[e] = (a[e] + b[e]) * zn;
              unpack8(rg[rr + 2], a); unpack8(ag[rr + 2], b);
#pragma unroll
              for (int e = 0; e < 8; ++e) ng[e] = (a[e] + b[e]) * zn; }
#pragma unroll
            for (int e = 0; e < 8; ++e) { const float v = pv[e] * wv[0][e] + cv[e] * wv[1][e] + nv[e] * wv[2][e] + bv[e], g = pg[e] * wg[0][e] + cg[e] * wg[1][e] + ng[e] * wg[2][e] + bg[e];
                o[e] = v * silu_f(g); pv[e] = cv[e]; pg[e] = cg[e]; cv[e] = nv[e]; cg[e] = ng[e]; }
            *(GAS v4u*)(ACT + (size_t)(R0 + rr) * DFF + c) = pack8(o);
        }
    }
}

__device__ __forceinline__ void conv_edge_rows(int gw, int NGW, int g_lo, int ncb, const float* EDGE, const float* cws, bf16* ACT) {
    const int lane = lane_id_opaque(); asm volatile("" : "+s"(gw), "+s"(NGW));
    const int nitems = (T / 256 - g_lo) * 2 * ncb;
    for (int it = gw; it < nitems; it += NGW) {
        const int ge = it / ncb, cbk = it - ge * ncb, g = g_lo + (ge >> 1), e = ge & 1, c = cbk * 512 + lane * 8;
        const bool nb = e == 0 ? (g >= 2) : (g != 0 && g != T / 256 - 1);
        const float* P = EDGE + (size_t)((g * 2 + e) * 2) * NUP + c;
        const float* R = EDGE + (size_t)(((e == 0 ? g - 1 : g + 1) * 2 + (1 - e)) * 2 + 1) * NUP + c;
        const float* wt = cws + (size_t)(e == 0 ? 0 : 2) * NUP + c;
        float o[8];
#pragma unroll
        for (int h = 0; h < 2; ++h) {
            f32x4 pv = *(const GAS f32x4*)(P + 4 * h), pg = *(const GAS f32x4*)(P + DFF + 4 * h);
            if (nb) { const f32x4 rv = *(const GAS f32x4*)(R + 4 * h), rg = *(const GAS f32x4*)(R + DFF + 4 * h), wv = *(const GAS f32x4*)(wt + 4 * h), wg = *(const GAS f32x4*)(wt + DFF + 4 * h);
                pv = pv + wv * rv; pg = pg + wg * rg; }
#pragma unroll
            for (int j = 0; j < 4; ++j) o[4 * h + j] = pv[j] * pg[j] * __builtin_amdgcn_rcpf(1.0f + __builtin_amdgcn_exp2f(pg[j]));
        }
        v4u w; w.x = pk2(o[0], o[1]); w.y = pk2(o[2], o[3]); w.z = pk2(o[4], o[5]); w.w = pk2(o[6], o[7]);
        *(GAS v4u*)(ACT + (size_t)(g * 256 + 255 * e) * DFF + c) = w;
    }
}

#ifndef REP_ATT
#define REP_ATT 1
#endif
#ifndef REP_UP
#define REP_UP 1
#endif
#ifndef REP_DFT
#define REP_DFT 1
#endif
#ifndef REP_PRO
#define REP_PRO 1
#endif
#ifndef REP_THIN
#define REP_THIN 1
#endif
struct Args { const float* in[20]; float* out; unsigned char* ws; };
typedef const __attribute__((address_space(4))) Args* kargs_t;
__device__ __forceinline__ kargs_t kargs() { kargs_t p = (kargs_t)__builtin_amdgcn_kernarg_segment_ptr(); asm volatile("" : "+s"(p)); return p; }
enum { I_X = 0, I_C, I_CTX, I_CCTX, I_ADAW, I_ADAB, I_N1G, I_N2G, I_WDQKV, I_QNG, I_KVNG, I_WUQ, I_WUKV, I_WO, I_FNOW, I_WUP, I_CONVW, I_CONVB, I_WDOWN, I_FNG };

__global__ void __launch_bounds__(NWAVES * 64, 2) fwd(Args args) {
    extern __shared__ __attribute__((aligned(16))) unsigned char lds[];
    LAS unsigned char* L = (LAS unsigned char*)lds;
    volatile LAS unsigned* MISC = (volatile LAS unsigned*)(L + MISC_OFF);
    const int tid = threadIdx.x, lane = tid & 63, wave = __builtin_amdgcn_readfirstlane(tid >> 6);
    const int G = gridDim.x, bx = blockIdx.x, vcu = (G % 8 == 0) ? (bx % 8) * (G / 8) + bx / 8 : bx;
    const int gw = vcu * NWAVES + wave, NGW = G * NWAVES;
    for (int u = tid; u < (LDS_BYTES - LDSCTL_OFF) / 4; u += NWAVES * 64) ((LAS unsigned*)(L + LDSCTL_OFF))[u] = 0u;
    __syncthreads();
    XcdBarrier bar = xcd_barrier_post((unsigned*)(kargs()->ws + WS_CTL) + CW_BAR, MISC + 8);
#define GRID_BAR() xcd_barrier(bar)

#define WSP(type, off) ((type*)(kargs()->ws + (off)))
#define IN(i) (kargs()->in[i])
#define MOD WSP(float, WS_MOD)
#define ROPE WSP(float, WS_ROPE)
#define WCT WSP(bf16, WS_WCT)
#define WCT4 WSP(bf16, WS_WCT4)
#define DSC WSP(bf16, WS_DSC)
#define DS WSP(bf16, WS_DS)
#define WDQ WSP(bf16, WS_WDQ)
#define WUQ WSP(bf16, WS_WUQ)
#define WUKV WSP(bf16, WS_WUKV)
#define WO WSP(bf16, WS_WO)
#define WFNO WSP(bf16, WS_WFNO)
#define WUP WSP(bf16, WS_WUP)
#define WDN WSP(bf16, WS_WDN)
#define XS WSP(bf16, WS_XS)
#define HN WSP(bf16, WS_HN)
#define SSQ WSP(float, WS_SSQ)
#define CQN WSP(bf16, WS_CQN)
#define CKVN WSP(bf16, WS_CKVN)
#define KR WSP(bf16, WS_KR)
#define Q WSP(bf16, WS_Q)
#define KV WSP(bf16, WS_KV)
#define O WSP(bf16, WS_O)
#define U WSP(bf16, WS_U)
#define ACT WSP(bf16, WS_ACT)
#define YT WSP(bf16, WS_YT)
#define YTC WSP(bf16, WS_YTC)
#define PART WSP(float, WS_PART)
#define U2C WSP(bf16, WS_U2C)
#define EDGE WSP(float, WS_EDGE)
#define CWS WSP(float, WS_CWS)
#define PQ WSP(bf16, WS_PQ)
#define H4B WSP(float, WS_H4)
#define V1B WSP(float, WS_V1)

    for (int rep = 0; rep < REP_PRO; ++rep) {
        LAS float* sx = (LAS float*)L;
        LAS float* red = (LAS float*)(L + 16384);
        for (int i = tid; i < DM; i += NWAVES * 64) { sx[i] = silu_f(IN(I_C)[i]); sx[DM + i] = silu_f(IN(I_CCTX)[i]); }
        __syncthreads();
        for (int it = bx; it < 256; it += G) {
            const int layer = it >> 6, n0 = (it & 63) * 192;
            f32x4 ax = {0.f, 0.f, 0.f, 0.f}, ac = {0.f, 0.f, 0.f, 0.f};
            if (lane < 48) {
                const float* W = IN(I_ADAW) + (size_t)layer * DM * (NMOD * DM) + n0 + lane * 4;
                for (int kk = 0; kk < 256; kk += 16) {
                    const int k = wave * 256 + kk; f32x4 w[16];
#pragma unroll
                    for (int u = 0; u < 16; ++u) w[u] = *(const GAS f32x4*)(W + (size_t)(k + u) * (NMOD * DM));
#pragma unroll
                    for (int u = 0; u < 16; ++u) { ax = ax + w[u] * sx[k + u]; ac = ac + w[u] * sx[DM + k + u]; }
                }
                *(LAS f32x4*)(red + (wave * 2 + 0) * 192 + lane * 4) = ax; *(LAS f32x4*)(red + (wave * 2 + 1) * 192 + lane * 4) = ac;
            }
            __syncthreads();
            if (tid < 384) { const int kind = tid / 192, col = tid - kind * 192; float s = IN(I_ADAB)[(size_t)layer * (NMOD * DM) + n0 + col];
#pragma unroll
                for (int w8 = 0; w8 < 8; ++w8) s += red[(w8 * 2 + kind) * 192 + col];
                MOD[(size_t)(layer * 2 + kind) * (NMOD * DM) + n0 + col] = s; }
            __syncthreads();
        }
        {
            LAS float* scr = (LAS float*)(L + RING_OFF + wave * 16384);
            constexpr int I_DQ = (DM / 64) * (NDQ / 32), I_UQ = (QL / 64) * (NUQ / 32), I_UKV = (KVL / 64) * (NUKV / 32), I_SQ = (DM / 64) * (DM / 32), I_UP = (DM / 64) * (NUP / 32), I_DN = (DFF / 64) * (DM / 32);
            constexpr int NITEMS = 2 * (I_DQ + I_UQ + I_UKV + I_SQ + I_SQ) + 4 * (I_UP + I_DN);
            for (int it = gw; it < NITEMS; it += NGW) {
                int r = it;
                if (r < 4 * I_UP) { const int l = r / I_UP; p0_transpose_item<2>(IN(I_WUP) + (size_t)l * DM * NUP, DM, NUP, WUP + (size_t)l * NUP * DM, scr, r - l * I_UP, lane); continue; } r -= 4 * I_UP;
                if (r < 4 * I_DN) { const int l = r / I_DN; p0_transpose_item<0>(IN(I_WDOWN) + (size_t)l * DFF * DM, DFF, DM, WDN + (size_t)l * DM * DFF, scr, r - l * I_DN, lane); continue; } r -= 4 * I_DN;
                if (r < 2 * I_DQ) { const int l = r / I_DQ; p0_transpose_item<3>(IN(I_WDQKV) + (size_t)l * DM * NDQ, DM, NDQ, WDQ + (size_t)l * NDQP * DM, scr, r - l * I_DQ, lane); continue; } r -= 2 * I_DQ;
                if (r < 2 * I_UQ) { const int l = r / I_UQ; p0_transpose_item<1>(IN(I_WUQ) + (size_t)l * QL * NUQ, QL, NUQ, WUQ + (size_t)l * NUQ * QL, scr, r - l * I_UQ, lane, IN(I_QNG) + (size_t)l * QL); continue; } r -= 2 * I_UQ;
                if (r < 2 * I_UKV) { const int l = r / I_UKV; p0_transpose_item<0>(IN(I_WUKV) + (size_t)l * KVL * NUKV, KVL, NUKV, WUKV + (size_t)l * NUKV * KVL, scr, r - l * I_UKV, lane, IN(I_KVNG) + (size_t)l * KVL); continue; } r -= 2 * I_UKV;
                if (r < 2 * I_SQ) { const int l = r / I_SQ; p0_transpose_item<0>(IN(I_WO) + (size_t)l * DM * DM, DM, DM, WO + (size_t)l * DM * DM, scr, r - l * I_SQ, lane); continue; } r -= 2 * I_SQ;
                { const int l = r / I_SQ; p0_transpose_item<0>(IN(I_FNOW) + (size_t)l * DM * DM, DM, DM, WFNO + (size_t)l * DM * DM, scr, r - l * I_SQ, lane); }
            }
            { const int per = (NDQP - NDQ) * DM / 8; const int gt = vcu * (NWAVES * 64) + tid, NT_ = G * NWAVES * 64;
              for (int i = gt; i < 2 * per; i += NT_) { const int l = i / per, e = i - l * per; *(GAS v4u*)(WDQ + (size_t)l * NDQP * DM + (size_t)NDQ * DM + (size_t)e * 8) = (v4u){0u, 0u, 0u, 0u}; } }
        }
        __syncthreads();
        {
            LAS float* tab = (LAS float*)L;
            for (int i = tid; i < 8192; i += NWAVES * 64) tab[i] = __builtin_amdgcn_cosf((float)i * (1.0f / 8192.0f));
            __syncthreads();
            const int gt = vcu * (NWAVES * 64) + tid, NT_ = G * NWAVES * 64;
            const float s8k = 0.011048543456039806f  , s16 = 0.0625f;
            for (int it = gt; it < 4 * (SEQ / 4) * (SEQ / 32); it += NT_) {
                const int per = (SEQ / 4) * (SEQ / 32), z = it / per, r = it - z * per, jj = r / (SEQ / 32), n0 = (r - jj * (SEQ / 32)) * 8, step = 2 * jj + (z & 1);
                int idx = (step * n0 + ((z >> 1) ? 8192 - 2048 : 0)) & 8191; float v[8];
#pragma unroll
                for (int e = 0; e < 8; ++e) { v[e] = tab[idx] * s8k; idx = (idx + step) & 8191; }
                v4u w; w.x = pk2(v[0], v[1]); w.y = pk2(v[2], v[3]); w.z = pk2(v[4], v[5]); w.w = pk2(v[6], v[7]);
                *(GAS v4u*)(DS + (size_t)z * (SEQ / 4) * (SEQ / 4) + (size_t)jj * (SEQ / 4) + n0) = w;
            }
            for (int it = gt; it < 1024 * 32; it += NT_) {
                const int r = it >> 5, c0 = (it & 31) * 8, l = r & 255, add = (r >= 512) ? (8192 - 2048) : 0; float v[8];
#pragma unroll
                for (int e = 0; e < 8; ++e) v[e] = tab[(l * (c0 + e) * 32 + add) & 8191] * s16;
                v4u w; w.x = pk2(v[0], v[1]); w.y = pk2(v[2], v[3]); w.z = pk2(v[4], v[5]); w.w = pk2(v[6], v[7]);
                *(GAS v4u*)(WCT4 + (size_t)r * 256 + c0) = w;
            }
            for (int it = gt; it < 512 * 32; it += NT_) {
                const int r = it >> 5, c0 = (it & 31) * 8, l = r & 255, add = (r >= 256) ? (8192 - 2048) : 0; float v[8];
#pragma unroll
                for (int e = 0; e < 8; ++e) v[e] = tab[(l * (c0 + e) * 32 + add) & 8191] * s16;
                v4u w; w.x = pk2(v[0], v[1]); w.y = pk2(v[2], v[3]); w.z = pk2(v[4], v[5]); w.w = pk2(v[6], v[7]);
                *(GAS v4u*)(WCT + (size_t)r * 256 + c0) = w;
            }
            for (int it = gt; it < 256 * 64; it += NT_) {
                const int k = it >> 6, n0 = (it & 63) * 8, add = (n0 >= 256) ? 2048 : 0; float v[8];
#pragma unroll
                for (int e = 0; e < 8; ++e) v[e] = tab[(k * ((n0 + e) & 255) * 32 + add) & 8191] * s16;
                v4u w; w.x = pk2(v[0], v[1]); w.y = pk2(v[2], v[3]); w.z = pk2(v[4], v[5]); w.w = pk2(v[6], v[7]);
                *(GAS v4u*)(DSC + (size_t)k * 512 + n0) = w;
            }
            for (int it = gt; it < DEPTH * 4 * NUP; it += NT_) {
                const int l = it / (4 * NUP), r = it - l * (4 * NUP), tp = r / NUP, n = r - tp * NUP;
                const float v = tp < 3 ? IN(I_CONVW)[((size_t)l * 3 + tp) * NUP + n] : IN(I_CONVB)[(size_t)l * NUP + n];
                CWS[it] = v * (n < DFF ? -0.6931471805599453f : -1.4426950408889634f);
            }
            for (int it = gt; it < SEQ * 32; it += NT_) {
                const int n = it >> 5, p = it & 31, half = p >> 4, j = p & 15;
                const float inv = __builtin_amdgcn_exp2f(-(float)j * (13.287712379549449f / 16.0f));
                const float ang = (float)(half ? (n & 63) : (n >> 6)) * inv;
                const float rev = ang * 0.15915494309189535f;
                const float fr = rev - floorf(rev);
                ROPE[(size_t)n * 64 + 2 * p] = __builtin_amdgcn_cosf(fr); ROPE[(size_t)n * 64 + 2 * p + 1] = __builtin_amdgcn_sinf(fr);
            }
        }
        GRID_BAR();
    }

    for (int layer = 0; layer < DEPTH; ++layer) {
        const bool mla = (layer & 1) == 0, ctx_adv = layer < 2;
        const int jm = layer >> 1;
        const float* modx = MOD + (size_t)(layer * 2 + 0) * (NMOD * DM); const float* modc = MOD + (size_t)(layer * 2 + 1) * (NMOD * DM);
        const int lo_tok = ctx_adv ? 0 : CTXL;
        const int nM_tok = (T - lo_tok) / 256;
        for (int rep = 0; rep < REP_THIN; ++rep) {
        if (mla) { norm_ctx_wg(vcu, G, wave, (LAS float*)(L + RING_OFF), XS, layer != 0, IN(I_CTX), IN(I_N1G) + (size_t)layer * DM, modc, 0, 1, HN, PART, (rep == 0 && layer == 2) ? DFF / 512 : 0);
                   norm_rows(gw, NGW, CTXL, T, XS, layer != 0, IN(I_X), IN(I_CTX), IN(I_N1G) + (size_t)layer * DM, modx, modc, 0, 1, HN, PART, 0); }
        else {
            if (ctx_adv) norm_ctx_wg(vcu, G, wave, (LAS float*)(L + RING_OFF), XS, true, nullptr, IN(I_N1G) + (size_t)layer * DM, modc, 0, 1, HN, PART, rep == 0 ? DFF / 512 : 0);
            norm_quad_rows(gw, NGW, XS, IN(I_N1G) + (size_t)layer * DM, modx, 0, 1, HN + (size_t)CTXL * DM, H4B);
        }
        }
        GRID_BAR();
        if (mla) {
            {
                pg8::Gemm g{HN, WDQ + (size_t)jm * NDQP * DM, DM, DM, DM, 0, 0, 0}; pg8::Order S; S.init(T / 256, NDQP / 256, 1, G, bx);
                pg8::EpiLatent E{CQN, CKVN, KR, SSQ, ROPE, CTXL, (LAS float*)(L + XCH_OFF)};
                pg8::gemm_phase<pg8::EpiLatent, pg8::Order, true, true>(L + RING_OFF, g, S, E, wave);
            }
            GRID_BAR();
            {
                const bf16* a0 = CQN + (size_t)lo_tok * QL; const bf16* b0 = WUQ + (size_t)jm * NUQ * QL; bf16* o0 = Q + (size_t)lo_tok * NUQ;
                pg8::Gemm g{a0, b0, QL, QL, QL, (long)((const char*)CKVN - (const char*)a0), (long)((const char*)(WUKV + (size_t)jm * NUKV * KVL) - (const char*)b0), 0};
                pg8::Order2 S; S.init(nM_tok, NUQ / 256, T / 256, NUKV / 256, G, bx);
                pg8::EpiBf16RS E{o0, NUQ, (long)(KV - o0), NUKV - NUQ, SSQ, lo_tok};
                pg8::gemm_phase<pg8::EpiBf16RS, pg8::Order2, true, true>(L + RING_OFF, g, S, E, wave);
            }
            GRID_BAR();
            {
                const int nunits = 512 + (ctx_adv ? 16 : 0); int vcu_ = vcu; asm volatile("" : "+s"(vcu_));
                for (int rep = 0; rep < REP_ATT; ++rep)
                for (int i = 0;; ++i) {
                    const int Lu = i * G + vcu_; if (Lu >= nunits) break;
                    int h, row0, seq, pos0; const float* rp;
                    if (Lu < 512) { h = Lu >> 5; const int qb = Lu & 31; row0 = CTXL + qb * 256; seq = T; pos0 = qb * 256; rp = ROPE; }
                    else { h = Lu - 512; row0 = 0; seq = CTXL; pos0 = 0; rp = nullptr; }
                    att::attn_unit(Q + (size_t)row0 * NUQ + h * 192, KV + h * 256, KV + h * 256 + 128, KR, O + (size_t)row0 * DM + h * 128, rp, pos0, seq, (char*)lds + RING_OFF, wave);
                }
            }
            GRID_BAR();
            {
                pg8::Gemm g{O + (size_t)CTXL * DM, WO + (size_t)jm * DM * DM, DM, DM, DM, 0, 0, 0}; pg8::Order S; S.init(SEQ / 256, DM / 256, 1, G, bx);
                pg8::EpiResid E{XS + (size_t)CTXL * DM, DM, modx + 2 * DM, modx + 2 * DM, 0};
                pg8::gemm_phase<pg8::EpiResid, pg8::Order, true, true>(L + RING_OFF, g, S, E, wave);
            }
            if (ctx_adv) {
                pg8::Gemm g{O, WO + (size_t)jm * DM * DM, DM, DM, 512, 512 * 2, 512 * 2, 0}; pg8::Order S; S.init(1, DM / 256, DM / 512, G, bx);
                pg8::EpiGatePart E{PART, DM, modc + 2 * DM};
                pg8::gemm_phase<pg8::EpiGatePart, pg8::Order, true, true>(L + RING_OFF, g, S, E, wave);
            }
            GRID_BAR();
        } else {
            if (bx < NG) {
                LAS float* h4s = (LAS float*)L; const int t_ = wave * 64 + lane_id_opaque();
                if (t_ < GC) { h4s[t_] = H4B[bx * GC + t_]; h4s[GC + t_] = H4B[DM + bx * GC + t_]; h4s[2 * GC + t_] = H4B[2 * DM + bx * GC + t_]; }
                __syncthreads();
                if (t_ < GC) { const bf16* wc_ = WCT + (size_t)t_ * GC; const bf16* ws_ = WCT + (size_t)(GC + t_) * GC; float a0 = 0.f, a1 = 0.f, a2 = 0.f;
                    for (int c = 0; c < GC; c += 8) { const v4u w = *(const GAS v4u*)(wc_ + c), x = *(const GAS v4u*)(ws_ + c);
#pragma unroll
                        for (int e = 0; e < 4; ++e) { a0 += bflo(w[e]) * h4s[c + 2 * e] + bfhi(w[e]) * h4s[c + 2 * e + 1]; a1 += bflo(w[e]) * h4s[GC + c + 2 * e] + bfhi(w[e]) * h4s[GC + c + 2 * e + 1];
                            a2 += bflo(x[e]) * h4s[2 * GC + c + 2 * e] + bfhi(x[e]) * h4s[2 * GC + c + 2 * e + 1]; } }
                    V1B[bx * GC + t_] = a0; V1B[DM + bx * GC + t_] = a1; V1B[2 * DM + bx * GC + t_] = a2; }
                __syncthreads();
            }
            {
                pg8::Gemm g{WCT4, HN + (size_t)CTXL * DM, GC, DM, GC, 0, (long)GC * 2, (long)(SEQ / 4) * DM * 2}; pg8::Order S; S.init(4, SEQ / 1024, NG, G, bx);
                pg8::EpiChDft E{YT, SEQ, SEQ / 4};
                pg8::gemm_phase<pg8::EpiChDft, pg8::Order, true, true>(L + RING_OFF, g, S, E, wave);
            }
            if (ctx_adv) {
                pg8::Gemm g{WCT, HN, GC, DM, GC, 0, (long)GC * 2, 0}; pg8::Order S; S.init(2, 1, NG, G, bx);
                pg8::EpiChDft E{YTC, 2 * CTXL, CTXL};
                pg8::gemm_phase<pg8::EpiChDft, pg8::Order, true, true>(L + RING_OFF, g, S, E, wave);
            }
            GRID_BAR();
            {
                pg8::Gemm g{DS, YT, SEQ / 4, SEQ, SEQ / 4, (long)(SEQ / 4) * (SEQ / 4) * 2, (long)(SEQ / 4) * 2, 0}; pg8::Order S; S.init(SEQ / 1024, DM / 256, 4, G, bx);
                pg8::EpiBf16 E{PQ, DM, (long)(SEQ / 4) * DM, 0};
                for (int rep = 0; rep < REP_DFT; ++rep)
                pg8::gemm_phase<pg8::EpiBf16, pg8::Order, true, true>(L + RING_OFF, g, S, E, wave);
            }
            if (ctx_adv) {
                pg8::Gemm g{DSC, YTC, 2 * CTXL, 2 * CTXL, 2 * CTXL, 0, 0, 0}; pg8::Order S; S.init(1, DM / 256, 1, G, bx);
                pg8::EpiBf16 E{O, DM, 0, 0};
                pg8::gemm_phase<pg8::EpiBf16, pg8::Order, true, true>(L + RING_OFF, g, S, E, wave);
            }
            GRID_BAR();
            for (int rep = 0; rep < REP_THIN; ++rep)
            fourier_combine_rows(gw, NGW, PQ, V1B, YT, O + (size_t)CTXL * DM);
            GRID_BAR();
            {
                pg8::Gemm g{O + (size_t)CTXL * DM, WFNO + (size_t)jm * DM * DM, DM, DM, DM, 0, 0, 0}; pg8::Order S; S.init(SEQ / 256, DM / 256, 1, G, bx);
                pg8::EpiResid E{XS + (size_t)CTXL * DM, DM, modx + 2 * DM, modx + 2 * DM, 0};
                pg8::gemm_phase<pg8::EpiResid, pg8::Order, true, true>(L + RING_OFF, g, S, E, wave);
            }
            if (ctx_adv) {
                pg8::Gemm g{O, WFNO + (size_t)jm * DM * DM, DM, DM, 512, 512 * 2, 512 * 2, 0}; pg8::Order S; S.init(1, DM / 256, DM / 512, G, bx);
                pg8::EpiGatePart E{PART, DM, modc + 2 * DM};
                pg8::gemm_phase<pg8::EpiGatePart, pg8::Order, true, true>(L + RING_OFF, g, S, E, wave);
            }
            GRID_BAR();
        }
        for (int rep = 0; rep < REP_THIN; ++rep)
        { if (ctx_adv) norm_ctx_wg(vcu, G, wave, (LAS float*)(L + RING_OFF), XS, true, nullptr, IN(I_N2G) + (size_t)layer * DM, modc, 3, 4, HN, PART, rep == 0 ? DM / 512 : 0);
          norm_rows(gw, NGW, CTXL, T, XS, true, nullptr, nullptr, IN(I_N2G) + (size_t)layer * DM, modx, modc, 3, 4, HN, PART, 0); }
        GRID_BAR();
        {
            { const int t_ = wave * 64 + lane_id_opaque(); if (t_ < 256) ((LAS float*)(L + XCH_OFF + 8192))[t_] = 0.f; }
            pg8::Gemm g{HN + (size_t)lo_tok * DM, WUP + (size_t)layer * NUP * DM, DM, DM, DM, 0, 0, 0}; pg8::Order S; S.init(nM_tok, ctx_adv ? 44 : 40, 1, G, bx);
            pg8::EpiConvGate E{ACT + (size_t)lo_tok * DFF, DFF, CWS + (size_t)layer * 4 * NUP, NUP, DFF, EDGE + (size_t)(lo_tok / 256) * 4 * NUP, (LAS float*)(L + XCH_OFF)};
            for (int rep = 0; rep < REP_UP; ++rep)
            pg8::gemm_phase<pg8::EpiConvGate, pg8::Order, true, true>(L + RING_OFF, g, S, E, wave);
        }
        if (!ctx_adv) {
            pg8::Gemm g{HN + (size_t)CTXL * DM, WUP + (size_t)layer * NUP * DM + (size_t)40 * 256 * DM, DM, DM, DM / 2, (long)(DM / 2) * 2, (long)(DM / 2) * 2, 0}; pg8::Order S; S.init(SEQ / 256, 4, 2, G, bx);
            pg8::EpiBf16 E{U + (size_t)CTXL * NUP + 40 * 256, NUP, (long)(U2C - (U + (size_t)CTXL * NUP + 40 * 256)), 1024 - NUP};
            for (int rep = 0; rep < REP_UP; ++rep)
            pg8::gemm_phase<pg8::EpiBf16, pg8::Order, true, true>(L + RING_OFF, g, S, E, wave);
        }
        GRID_BAR();
        for (int rep = 0; rep < REP_THIN; ++rep) {
            conv_edge_rows(gw, NGW, lo_tok / 256, ctx_adv ? 11 : 10, EDGE, CWS + (size_t)layer * 4 * NUP, ACT);
            if (!ctx_adv) conv_tail_rows(gw, NGW, U, U2C, IN(I_CONVW) + (size_t)layer * 3 * NUP, IN(I_CONVB) + (size_t)layer * NUP, ACT);
        }
        GRID_BAR();
        {
            pg8::Gemm g{ACT + (size_t)CTXL * DFF, WDN + (size_t)layer * DM * DFF, DFF, DFF, DFF, 0, 0, 0}; pg8::Order S; S.init(SEQ / 256, DM / 256, 1, G, bx);
            pg8::EpiResid E{XS + (size_t)CTXL * DM, DM, modx + 5 * DM, modx + 5 * DM, 0};
            pg8::gemm_phase<pg8::EpiResid, pg8::Order, true, true>(L + RING_OFF, g, S, E, wave);
        }
        if (ctx_adv) {
            pg8::Gemm g{ACT, WDN + (size_t)layer * DM * DFF, DFF, DFF, 512, 512 * 2, 512 * 2, 0}; pg8::Order S; S.init(1, DM / 256, DFF / 512, G, bx);
            pg8::EpiGatePart E{PART, DM, modc + 5 * DM};
            pg8::gemm_phase<pg8::EpiGatePart, pg8::Order, true, true>(L + RING_OFF, g, S, E, wave);
        }
        GRID_BAR();
    }
    final_norm_rows(gw, NGW, XS, IN(I_FNG), kargs()->out);
#undef GRID_BAR
#undef WSP
#undef IN
#undef MOD
#undef ROPE
#undef WCT
#undef WCT4
#undef DSC
#undef DS
#undef WDQ
#undef WUQ
#undef WUKV
#undef WO
#undef WFNO
#undef WUP
#undef WDN
#undef XS
#undef HN
#undef SSQ
#undef CQN
#undef CKVN
#undef KR
#undef Q
#undef KV
#undef O
#undef U
#undef ACT
#undef YT
#undef YTC
#undef PART
#undef U2C
#undef EDGE
#undef CWS
#undef PQ
#undef H4B
#undef V1B
}

extern "C" void kernel_launch(void* const* d_in, const int* in_sizes, int n_in, void* d_out, int out_size, void* d_ws, size_t ws_size, hipStream_t stream) {
    static int grid = 0;
    if (grid == 0) {
        if (n_in != 20 || in_sizes[0] != SEQ * DM || out_size != SEQ * DM || ws_size < WS_END) { fprintf(stderr, "kernel_launch: unexpected shapes: n_in %d in0 %d out %d ws %zu (need %zu)\n", n_in, n_in > 0 ? in_sizes[0] : -1, out_size, ws_size, (size_t)WS_END); grid = -1; return; }
        int dev = 0, cus = 0, per_cu = 0;
        if (hipGetDevice(&dev) != hipSuccess || hipDeviceGetAttribute(&cus, hipDeviceAttributeMultiprocessorCount, dev) != hipSuccess) { fprintf(stderr, "kernel_launch: device query failed\n"); grid = -1; return; }
        if (hipFuncSetAttribute((const void*)fwd, hipFuncAttributeMaxDynamicSharedMemorySize, LDS_BYTES) != hipSuccess) { fprintf(stderr, "kernel_launch: hipFuncSetAttribute failed\n"); grid = -1; return; }
        if (hipOccupancyMaxActiveBlocksPerMultiprocessor(&per_cu, (const void*)fwd, NWAVES * 64, LDS_BYTES) != hipSuccess || per_cu < 1)
            fprintf(stderr, "kernel_launch: note: occupancy query reports %d workgroups per CU\n", per_cu);
        (void)hipGetLastError();
        grid = cus;
    }
    if (grid < 0) return;
    if (hipMemsetAsync((char*)d_ws + WS_CTL, 0, CTL_ZERO_BYTES, stream) != hipSuccess) { fprintf(stderr, "kernel_launch: hipMemsetAsync failed\n"); return; }
    Args a{};
    for (int i = 0; i < 20; ++i) a.in[i] = (const float*)d_in[i];
    a.out = (float*)d_out; a.ws = (unsigned char*)d_ws;
    hipLaunchKernelGGL(fwd, dim3(grid), dim3(NWAVES * 64), LDS_BYTES, stream, a);
    const hipError_t le = hipPeekAtLastError();
    if (le != hipSuccess) fprintf(stderr, "kernel_launch: launch failed: %s\n", hipGetErrorName(le));
}
```

```cpp
#include <hip/hip_runtime.h>
#include <hip/hip_bf16.h>
#include <cstdio>
#include <cstdint>
#include <cmath>
namespace pg8 {
#define PG8_LAS __attribute__((address_space(3)))
typedef unsigned short bf16_t;
typedef short bf16x8 __attribute__((ext_vector_type(8)));
typedef float f32x4 __attribute__((ext_vector_type(4)));
typedef unsigned u32x4 __attribute__((ext_vector_type(4)));
constexpr int BM = 256, BK = 64, HALF = 128, HTB = HALF * BK * 2  , STAGE_BYTES = 8 * HTB, NXCD = 8, WGM = 8;

__host__ __device__ __forceinline__ int lds_byte(int r, int c) { const int st = (r >> 4) * 2 + (c >> 5), rr = r & 15, cc = c & 31, ob = rr * 64 + cc * 2; return st * 1024 + (ob ^ (((ob >> 9) & 1) << 5)); }
__host__ __device__ __forceinline__ void stage_rc(int b, int& R, int& C) { const int st = b / 1024, sb = b % 1024, swz = sb ^ (((sb >> 9) & 1) << 5); R = (st >> 1) * 16 + swz / 64; C = (st & 1) * 32 + (swz % 64) / 2; }
__host__ __device__ __forceinline__ int perm32(int rho) { const int n = rho >> 4, i = rho & 15; return 8 * (i >> 2) + 4 * n + (i & 3); }

struct Unit { int pm, pn, z; };
struct Gemm { const bf16_t* A; const bf16_t* Bt; int lda, ldb, K; long sAz, sBz, sBm; };

struct Order {
    int nM, nN, nMN, ntot, G, c;
    __device__ __forceinline__ void init(int nM_, int nN_, int nZ, int G_, int c_) { nM = nM_; nN = nN_; nMN = nM_ * nN_; ntot = nMN * nZ; G = G_; c = c_; asm volatile("" : "+s"(c)); }
    __device__ __forceinline__ bool next(int i, Unit& u) const {
        const int L = i * G + c; if (L >= ntot) return false;
        u.z = L / nMN; int wgid = L - u.z * nMN;
        { const int q = nMN / NXCD, r = nMN % NXCD, xcd = wgid % NXCD, off = wgid / NXCD; wgid = (xcd < r ? xcd * (q + 1) : r * (q + 1) + (xcd - r) * q) + off; }
        const int nig = WGM * nN, gid = wgid / nig, fm = gid * WGM, gsz = (nM - fm) < WGM ? (nM - fm) : WGM;
        u.pm = fm + ((wgid % nig) % gsz); u.pn = (wgid % nig) / gsz; return true;
    }
};

struct Order2 {
    int nM0, nN0, n0, nM1, nN1, n1, G, c;
    __device__ __forceinline__ void init(int nM0_, int nN0_, int nM1_, int nN1_, int G_, int c_) { nM0 = nM0_; nN0 = nN0_; n0 = nM0_ * nN0_; nM1 = nM1_; nN1 = nN1_; n1 = nM1_ * nN1_; G = G_; c = c_; asm volatile("" : "+s"(c)); }
    __device__ __forceinline__ bool next(int i, Unit& u) const {
        const int L = i * G + c; if (L >= n0 + n1) return false;
        const bool p1 = L >= n0; u.z = p1 ? 1 : 0; int wgid = p1 ? L - n0 : L; const int nM = p1 ? nM1 : nM0, nN = p1 ? nN1 : nN0, nMN = p1 ? n1 : n0;
        { const int q = nMN / NXCD, r = nMN % NXCD, xcd = wgid % NXCD, off = wgid / NXCD; wgid = (xcd < r ? xcd * (q + 1) : r * (q + 1) + (xcd - r) * q) + off; }
        const int nig = WGM * nN, gid = wgid / nig, fm = gid * WGM, gsz = (nM - fm) < WGM ? (nM - fm) : WGM;
        u.pm = fm + ((wgid % nig) % gsz); u.pn = (wgid % nig) / gsz; return true;
    }
};

__device__ __forceinline__ unsigned cvt_pk_bf16(float lo, float hi) { unsigned r; asm volatile("v_cvt_pk_bf16_f32 %0, %1, %2" : "=v"(r) : "v"(lo), "v"(hi)); return r; }

struct EpiBf16 {
    static constexpr bool PERM = true, APERM = false;
    bf16_t* O; int ldc; long zs; int dldc;
    __device__ __forceinline__ void operator()(const f32x4 (&acc)[2][2][4][2], const Unit& u, int wr, int wc, int fr, int fq) const {
        const int row0 = u.pm * BM + wr * 64 + fr, col0 = u.pn * BM + wc * 32 + 8 * fq, ld = ldc + u.z * dldc;
#pragma unroll
        for (int ai = 0; ai < 2; ++ai)
#pragma unroll
            for (int m = 0; m < 4; ++m) { bf16_t* rowp = O + (size_t)u.z * zs + (size_t)(row0 + ai * HALF + m * 16) * ld + col0;
#pragma unroll
                for (int bj = 0; bj < 2; ++bj) { const f32x4 v0 = acc[ai][bj][m][0], v1 = acc[ai][bj][m][1];
                    u32x4 w; w.x = cvt_pk_bf16(v0[0], v0[1]); w.y = cvt_pk_bf16(v0[2], v0[3]); w.z = cvt_pk_bf16(v1[0], v1[1]); w.w = cvt_pk_bf16(v1[2], v1[3]);
                    *(u32x4*)(rowp + bj * HALF) = w; } }
    }
};
struct EpiChDft {
    static constexpr bool PERM = true, APERM = false;
    bf16_t* Y; int ldy; int part_stride;
    __device__ __forceinline__ void operator()(const f32x4 (&acc)[2][2][4][2], const Unit& u, int wr, int wc, int fr, int fq) const {
        const int row0 = u.z * BM + wr * 64 + fr, col0 = u.pm * part_stride + u.pn * BM + wc * 32 + 8 * fq;
#pragma unroll
        for (int ai = 0; ai < 2; ++ai)
#pragma unroll
            for (int m = 0; m < 4; ++m) { bf16_t* rowp = Y + (size_t)(row0 + ai * HALF + m * 16) * ldy + col0;
#pragma unroll
                for (int bj = 0; bj < 2; ++bj) { const f32x4 v0 = acc[ai][bj][m][0], v1 = acc[ai][bj][m][1];
                    u32x4 w; w.x = cvt_pk_bf16(v0[0], v0[1]); w.y = cvt_pk_bf16(v0[2], v0[3]); w.z = cvt_pk_bf16(v1[0], v1[1]); w.w = cvt_pk_bf16(v1[2], v1[3]);
                    *(u32x4*)(rowp + bj * HALF) = w; } }
    }
};
struct EpiF32 {
    static constexpr bool PERM = false, APERM = false;
    float* C; int ldc;
    __device__ __forceinline__ void operator()(const f32x4 (&acc)[2][2][4][2], const Unit& u, int wr, int wc, int fr, int fq) const {
        const int row0 = u.pm * BM + wr * 64 + fr, col0 = u.pn * BM + wc * 32 + 4 * fq;
#pragma unroll
        for (int ai = 0; ai < 2; ++ai)
#pragma unroll
            for (int m = 0; m < 4; ++m) { float* rowp = C + (size_t)(row0 + ai * HALF + m * 16) * ldc + col0;
#pragma unroll
                for (int bj = 0; bj < 2; ++bj)
#pragma unroll
                    for (int n = 0; n < 2; ++n) *(f32x4*)(rowp + bj * HALF + n * 16) = acc[ai][bj][m][n]; }
    }
};
struct EpiResid {
    static constexpr bool PERM = true, APERM = false;
    bf16_t* X; int ldc; const float* gate_ctx; const float* gate_x; int ctx_tile0;
    __device__ __forceinline__ void operator()(const f32x4 (&acc)[2][2][4][2], const Unit& u, int wr, int wc, int fr, int fq) const {
        const int row0 = u.pm * BM + wr * 64 + fr, col0 = u.pn * BM + wc * 32 + 8 * fq;
        const float* gate = (ctx_tile0 && u.pm == 0) ? gate_ctx : gate_x;
        f32x4 gv[2][2];
#pragma unroll
        for (int bj = 0; bj < 2; ++bj)
#pragma unroll
            for (int n = 0; n < 2; ++n) gv[bj][n] = *(const f32x4*)(gate + col0 + bj * HALF + 4 * n);
#pragma unroll
        for (int ai = 0; ai < 2; ++ai)
#pragma unroll
            for (int m = 0; m < 4; ++m) { bf16_t* rowp = X + (size_t)(row0 + ai * HALF + m * 16) * ldc + col0;
#pragma unroll
                for (int bj = 0; bj < 2; ++bj) { const u32x4 xw = *(const u32x4*)(rowp + bj * HALF);
                    const f32x4 x0 = {__uint_as_float(xw.x << 16), __uint_as_float(xw.x & 0xffff0000u), __uint_as_float(xw.y << 16), __uint_as_float(xw.y & 0xffff0000u)};
                    const f32x4 x1 = {__uint_as_float(xw.z << 16), __uint_as_float(xw.z & 0xffff0000u), __uint_as_float(xw.w << 16), __uint_as_float(xw.w & 0xffff0000u)};
                    const f32x4 v0 = x0 + gv[bj][0] * acc[ai][bj][m][0], v1 = x1 + gv[bj][1] * acc[ai][bj][m][1];
                    u32x4 w; w.x = cvt_pk_bf16(v0[0], v0[1]); w.y = cvt_pk_bf16(v0[2], v0[3]); w.z = cvt_pk_bf16(v1[0], v1[1]); w.w = cvt_pk_bf16(v1[2], v1[3]);
                    *(u32x4*)(rowp + bj * HALF) = w; }
                if (m & 1) asm volatile("" ::: "memory"); }
    }
};

struct EpiGatePart {
    static constexpr bool PERM = false, APERM = false;
    float* P; int ldc; const float* gate;
    __device__ __forceinline__ void operator()(const f32x4 (&acc)[2][2][4][2], const Unit& u, int wr, int wc, int fr, int fq) const {
        const int row0 = u.z * BM + u.pm * BM + wr * 64 + fr, col0 = u.pn * BM + wc * 32 + 4 * fq;
        f32x4 gv[2][2];
#pragma unroll
        for (int bj = 0; bj < 2; ++bj)
#pragma unroll
            for (int n = 0; n < 2; ++n) gv[bj][n] = *(const f32x4*)(gate + col0 + bj * HALF + n * 16);
#pragma unroll
        for (int ai = 0; ai < 2; ++ai)
#pragma unroll
            for (int m = 0; m < 4; ++m) { float* rowp = P + (size_t)(row0 + ai * HALF + m * 16) * ldc + col0;
#pragma unroll
                for (int bj = 0; bj < 2; ++bj)
#pragma unroll
                    for (int n = 0; n < 2; ++n) *(f32x4*)(rowp + bj * HALF + n * 16) = gv[bj][n] * acc[ai][bj][m][n]; }
    }
};

template <int CTRL> __device__ __forceinline__ float dpp_keep(float old, float src) {
    return __builtin_bit_cast(float, __builtin_amdgcn_update_dpp(__builtin_bit_cast(int, old), __builtin_bit_cast(int, src), CTRL, 0xf, 0xf, false));
}
typedef float f32x2 __attribute__((ext_vector_type(2)));
struct EpiConvGate {
    static constexpr bool PERM = true, APERM = true;
    bf16_t* ACT; int ldact; const float* cws; int nup, dff; float* EDGE; PG8_LAS float* xch;
    __device__ __forceinline__ void operator()(const f32x4 (&acc)[2][2][4][2], const Unit& u, int wr, int wc, int fr, int fq) const {
        const int cl = wc * 32 + 8 * fq, colb = u.pn * 128 + cl;
        if (fr == 0) {
#pragma unroll
            for (int ai = 0; ai < 2; ++ai)
#pragma unroll
                for (int bj = 0; bj < 2; ++bj)
#pragma unroll
                    for (int n = 0; n < 2; ++n) *(PG8_LAS f32x4*)(xch + ((((wr * 2 + ai) * 2 + 0) * 2 + bj) * 128) + cl + 4 * n) = acc[ai][bj][0][n];
        }
        if (fr == 15) {
#pragma unroll
            for (int ai = 0; ai < 2; ++ai)
#pragma unroll
                for (int bj = 0; bj < 2; ++bj)
#pragma unroll
                    for (int n = 0; n < 2; ++n) *(PG8_LAS f32x4*)(xch + ((((wr * 2 + ai) * 2 + 1) * 2 + bj) * 128) + cl + 4 * n) = acc[ai][bj][3][n];
        }
        asm volatile("s_waitcnt lgkmcnt(0)" ::: "memory"); __builtin_amdgcn_s_barrier();
        const int ZB = 2048;
        const int top0 = wr == 1 ? (((0 * 2 + 0) * 2 + 1) * 2) * 128 : ZB, top1 = wr == 1 ? (((0 * 2 + 1) * 2 + 1) * 2) * 128 : (((1 * 2 + 0) * 2 + 1) * 2) * 128;
        const int bot0 = wr == 0 ? (((1 * 2 + 0) * 2 + 0) * 2) * 128 : (((0 * 2 + 1) * 2 + 0) * 2) * 128, bot1 = wr == 0 ? (((1 * 2 + 1) * 2 + 0) * 2) * 128 : ZB;
        unsigned op[2][4][2][2];
#pragma unroll
        for (int n = 0; n < 2; ++n) {
            f32x4 w[2][3], b[2];
#pragma unroll
            for (int bj = 0; bj < 2; ++bj) { b[bj] = *(const f32x4*)(cws + (size_t)3 * nup + bj * dff + colb + 4 * n);
#pragma unroll
                for (int tp = 0; tp < 3; ++tp) w[bj][tp] = *(const f32x4*)(cws + (size_t)tp * nup + bj * dff + colb + 4 * n); }
#pragma unroll
            for (int ai = 0; ai < 2; ++ai) {
                f32x2 pre[2][4][2];
#pragma unroll
                for (int bj = 0; bj < 2; ++bj) {
                    const f32x4 ht = *(const PG8_LAS f32x4*)(xch + (ai == 0 ? top0 : top1) + bj * 128 + cl + 4 * n), hb = *(const PG8_LAS f32x4*)(xch + (ai == 0 ? bot0 : bot1) + bj * 128 + cl + 4 * n);
#pragma unroll
                    for (int jp = 0; jp < 2; ++jp) { const int j = 2 * jp;
                        const f32x2 u0 = {acc[ai][bj][0][n][j], acc[ai][bj][0][n][j + 1]}, u1 = {acc[ai][bj][1][n][j], acc[ai][bj][1][n][j + 1]}, u2 = {acc[ai][bj][2][n][j], acc[ai][bj][2][n][j + 1]}, u3 = {acc[ai][bj][3][n][j], acc[ai][bj][3][n][j + 1]};
                        const f32x2 pv = {dpp_keep<0x111>(ht[j], u3[0]), dpp_keep<0x111>(ht[j + 1], u3[1])};
                        const f32x2 nx = {dpp_keep<0x101>(hb[j], u0[0]), dpp_keep<0x101>(hb[j + 1], u0[1])};
                        const f32x2 w0 = {w[bj][0][j], w[bj][0][j + 1]}, w1 = {w[bj][1][j], w[bj][1][j + 1]}, w2 = {w[bj][2][j], w[bj][2][j + 1]}, bb = {b[bj][j], b[bj][j + 1]};
                        pre[bj][0][jp] = w2 * u1 + (w0 * pv + (w1 * u0 + bb));
                        pre[bj][1][jp] = w2 * u2 + (w0 * u0 + (w1 * u1 + bb));
                        pre[bj][2][jp] = w2 * u3 + (w0 * u1 + (w1 * u2 + bb));
                        pre[bj][3][jp] = w2 * nx + (w0 * u2 + (w1 * u3 + bb));
                    }
                }
                if (wr == 0 && ai == 0 && fr == 0) {
                    float* e = EDGE + (size_t)((u.pm * 2 + 0) * 2) * nup + colb + 4 * n;
                    *(f32x4*)(e) = (f32x4){pre[0][0][0][0], pre[0][0][0][1], pre[0][0][1][0], pre[0][0][1][1]}; *(f32x4*)(e + dff) = (f32x4){pre[1][0][0][0], pre[1][0][0][1], pre[1][0][1][0], pre[1][0][1][1]};
                    *(f32x4*)(e + nup) = acc[0][0][0][n]; *(f32x4*)(e + nup + dff) = acc[0][1][0][n];
                }
                if (wr == 1 && ai == 1 && fr == 15) {
                    float* e = EDGE + (size_t)((u.pm * 2 + 1) * 2) * nup + colb + 4 * n;
                    *(f32x4*)(e) = (f32x4){pre[0][3][0][0], pre[0][3][0][1], pre[0][3][1][0], pre[0][3][1][1]}; *(f32x4*)(e + dff) = (f32x4){pre[1][3][0][0], pre[1][3][0][1], pre[1][3][1][0], pre[1][3][1][1]};
                    *(f32x4*)(e + nup) = acc[1][0][3][n]; *(f32x4*)(e + nup + dff) = acc[1][1][3][n];
                }
#pragma unroll
                for (int m = 0; m < 4; ++m)
#pragma unroll
                    for (int jp = 0; jp < 2; ++jp) { const f32x2 t = pre[1][m][jp]; const f32x2 e2 = {__builtin_amdgcn_exp2f(t[0]), __builtin_amdgcn_exp2f(t[1])}; const f32x2 d = e2 + 1.0f;
                        const f32x2 r = {__builtin_amdgcn_rcpf(d[0]), __builtin_amdgcn_rcpf(d[1])}; const f32x2 o = (pre[0][m][jp] * t) * r;
                        op[ai][m][n][jp] = cvt_pk_bf16(o[0], o[1]); }
            }
        }
        char* abase = (char*)(ACT + (size_t)u.pm * BM * ldact);
        const unsigned vo = (unsigned)((wr * 64 + 4 * fr) * ldact + colb) * 2u;
#pragma unroll
        for (int ai = 0; ai < 2; ++ai)
#pragma unroll
            for (int m = 0; m < 4; ++m) { u32x4 wv; wv.x = op[ai][m][0][0]; wv.y = op[ai][m][0][1]; wv.z = op[ai][m][1][0]; wv.w = op[ai][m][1][1];
                *(u32x4*)(abase + (vo + (unsigned)((ai * HALF + m) * ldact) * 2u)) = wv; }
    }
};

struct EpiLatent {
    static constexpr bool PERM = true, APERM = false;
    bf16_t* CQ; bf16_t* CKV; bf16_t* KR; float* SSQ; const float* rope; int ctxl; PG8_LAS float* xch;
    __device__ __forceinline__ void operator()(const f32x4 (&acc)[2][2][4][2], const Unit& u, int wr, int wc, int fr, int fq) const {
        const int row0 = u.pm * BM + wr * 64 + fr, cl = wc * 32 + 8 * fq;
        if (u.pn < 4) {
            bf16_t* O = (u.pn < 2 ? CQ : CKV) + (u.pn & 1) * 256 + cl;
            float ss[2][4];
#pragma unroll
            for (int ai = 0; ai < 2; ++ai)
#pragma unroll
                for (int m = 0; m < 4; ++m) { bf16_t* rowp = O + (size_t)(row0 + ai * HALF + m * 16) * 512; float s = 0.f;
#pragma unroll
                    for (int bj = 0; bj < 2; ++bj) { const f32x4 v0 = acc[ai][bj][m][0], v1 = acc[ai][bj][m][1];
                        s += (v0[0] * v0[0] + v0[1] * v0[1]) + (v0[2] * v0[2] + v0[3] * v0[3]) + (v1[0] * v1[0] + v1[1] * v1[1]) + (v1[2] * v1[2] + v1[3] * v1[3]);
                        u32x4 w; w.x = cvt_pk_bf16(v0[0], v0[1]); w.y = cvt_pk_bf16(v0[2], v0[3]); w.z = cvt_pk_bf16(v1[0], v1[1]); w.w = cvt_pk_bf16(v1[2], v1[3]);
                        *(u32x4*)(rowp + bj * HALF) = w; }
                    ss[ai][m] = s; }
            const int lane = fq * 16 + fr;
#pragma unroll
            for (int ai = 0; ai < 2; ++ai)
#pragma unroll
                for (int m = 0; m < 4; ++m) { float s = ss[ai][m];
                    s += __builtin_bit_cast(float, __builtin_amdgcn_ds_bpermute((lane ^ 16) << 2, __builtin_bit_cast(int, s)));
                    s += __builtin_bit_cast(float, __builtin_amdgcn_ds_bpermute((lane ^ 32) << 2, __builtin_bit_cast(int, s)));
                    if (fq == 0) xch[((wr * 4 + wc) * 8 + ai * 4 + m) * 16 + fr] = s; }
        } else if (wc < 2) {
#pragma unroll
            for (int ai = 0; ai < 2; ++ai)
#pragma unroll
                for (int m = 0; m < 4; ++m) { const int row = row0 + ai * HALF + m * 16; f32x4 v0 = acc[ai][0][m][0], v1 = acc[ai][0][m][1];
                    if (row >= ctxl) { const float* rp = rope + (size_t)(row - ctxl) * 64 + cl; const f32x4 c0 = *(const f32x4*)(rp), c1 = *(const f32x4*)(rp + 4);
                        const f32x4 r0 = {v0[0] * c0[0] - v0[1] * c0[1], v0[1] * c0[0] + v0[0] * c0[1], v0[2] * c0[2] - v0[3] * c0[3], v0[3] * c0[2] + v0[2] * c0[3]};
                        const f32x4 r1 = {v1[0] * c1[0] - v1[1] * c1[1], v1[1] * c1[0] + v1[0] * c1[1], v1[2] * c1[2] - v1[3] * c1[3], v1[3] * c1[2] + v1[2] * c1[3]};
                        v0 = r0; v1 = r1; }
                    u32x4 w; w.x = cvt_pk_bf16(v0[0], v0[1]); w.y = cvt_pk_bf16(v0[2], v0[3]); w.z = cvt_pk_bf16(v1[0], v1[1]); w.w = cvt_pk_bf16(v1[2], v1[3]);
                    *(u32x4*)(KR + (size_t)row * 64 + cl) = w; }
        }
        asm volatile("s_waitcnt lgkmcnt(0)" ::: "memory"); __builtin_amdgcn_s_barrier();
        if (u.pn < 4 && wc == 0 && fq == 0) {
#pragma unroll
            for (int ai = 0; ai < 2; ++ai)
#pragma unroll
                for (int m = 0; m < 4; ++m) { float s = 0.f;
#pragma unroll
                    for (int w4 = 0; w4 < 4; ++w4) s += xch[((wr * 4 + w4) * 8 + ai * 4 + m) * 16 + fr];
                    SSQ[(size_t)(row0 + ai * HALF + m * 16) * 4 + u.pn] = s; }
        }
    }
};
struct EpiBf16RS {
    static constexpr bool PERM = true, APERM = false;
    bf16_t* O; int ldc; long zs; int dldc; const float* SSQ; int row_off0;
    __device__ __forceinline__ void operator()(const f32x4 (&acc)[2][2][4][2], const Unit& u, int wr, int wc, int fr, int fq) const {
        const int row0 = u.pm * BM + wr * 64 + fr, col0 = u.pn * BM + wc * 32 + 8 * fq, ld = ldc + u.z * dldc;
        const float* sq = SSQ + (size_t)(row0 + (u.z == 0 ? row_off0 : 0)) * 4 + 2 * u.z;
#pragma unroll
        for (int ai = 0; ai < 2; ++ai)
#pragma unroll
            for (int m = 0; m < 4; ++m) { bf16_t* rowp = O + (size_t)u.z * zs + (size_t)(row0 + ai * HALF + m * 16) * ld + col0;
                const float* sp = sq + (size_t)(ai * HALF + m * 16) * 4; const float rs = 1.0f / sqrtf((sp[0] + sp[1]) * (1.f / 512.f) + 1e-6f);
#pragma unroll
                for (int bj = 0; bj < 2; ++bj) { const f32x4 v0 = acc[ai][bj][m][0] * rs, v1 = acc[ai][bj][m][1] * rs;
                    u32x4 w; w.x = cvt_pk_bf16(v0[0], v0[1]); w.y = cvt_pk_bf16(v0[2], v0[3]); w.z = cvt_pk_bf16(v1[0], v1[1]); w.w = cvt_pk_bf16(v1[2], v1[3]);
                    *(u32x4*)(rowp + bj * HALF) = w; } }
    }
};

template <class Epi, class Sched, bool ALIGN_EPI = false, bool SP2 = false>
__device__ __forceinline__ void gemm_phase(PG8_LAS unsigned char* lds, const Gemm g, const Sched& S, const Epi& E, int wid  ) {
    int lane; asm volatile("v_mbcnt_lo_u32_b32 %0, -1, 0\n\tv_mbcnt_hi_u32_b32 %0, -1, %0" : "=v"(lane));
    const int tid = wid * 64 + lane, wr = wid >> 2, wc = wid & 3, fr = lane & 15, fq = lane >> 4;
    const int K = g.K, nt = K / BK;
    unsigned voffA[2], voffB[2];
#pragma unroll
    for (int i = 0; i < 2; ++i) { int R, C; stage_rc(tid * 16 + i * 8192, R, C); const int Rb = Epi::PERM ? ((R & ~31) + perm32(R & 31)) : R; const int Ra = Epi::APERM ? ((R & ~63) + 4 * (R & 15) + ((R >> 4) & 3)) : R;
        voffA[i] = (unsigned)(Ra * g.lda + C) * 2u; voffB[i] = (unsigned)(Rb * g.ldb + C) * 2u; }
    const size_t kstep = (size_t)(BK * 2);
    const size_t hstepA = (size_t)HALF * g.lda * 2, hstepB = (size_t)HALF * g.ldb * 2;
    const size_t tstepA = 2 * hstepA, tstepB = 2 * hstepB;
    const unsigned ldsw = (unsigned)wid * 1024u;
    const int aoff = lds_byte(wr * 64 + fr, fq * 8), boff = lds_byte(wc * 32 + fr, fq * 8);
#define PG8_SA(b, h) (((b) * 2 + (h)) * HTB)
#define PG8_SB(b, h) ((4 + (b) * 2 + (h)) * HTB)
#define PG8_STAGE(bufoff, gbase, voff) do { const char* gb_ = (const char*)(gbase); asm volatile("" : "+s"(gb_));     \
        _Pragma("unroll") for (int _i = 0; _i < 2; ++_i) { asm volatile("" : "+v"((voff)[_i])); \
        __builtin_amdgcn_global_load_lds((const unsigned*)(gb_ + (voff)[_i]), (PG8_LAS unsigned*)(lds + (bufoff) + ldsw + _i * 8192), 16, 0, 0); } } while (0)
#define PG8_LDA(dst, b, h) do { _Pragma("unroll") for (int m = 0; m < 4; ++m) _Pragma("unroll") for (int k = 0; k < 2; ++k) dst[m][k] = *(const PG8_LAS bf16x8*)(lds + PG8_SA(b, h) + aoff + m * 2048 + k * 1024); } while (0)
#define PG8_LDB(dst, b, h) do { _Pragma("unroll") for (int n = 0; n < 2; ++n) _Pragma("unroll") for (int k = 0; k < 2; ++k) dst[n][k] = *(const PG8_LAS bf16x8*)(lds + PG8_SB(b, h) + boff + n * 2048 + k * 1024); } while (0)
#define PG8_MMA(ai, bj, At, Bt) do { __builtin_amdgcn_s_setprio(1); _Pragma("unroll") for (int m = 0; m < 4; ++m) _Pragma("unroll") for (int n = 0; n < 2; ++n) _Pragma("unroll") for (int k = 0; k < 2; ++k) \
        acc[ai][bj][m][n] = __builtin_amdgcn_mfma_f32_16x16x32_bf16(Bt[n][k], At[m][k], acc[ai][bj][m][n], 0, 0, 0); __builtin_amdgcn_s_setprio(0); } while (0)
#define PG8_WAIT_V(n) asm volatile("s_waitcnt vmcnt(" #n ")" ::: "memory")
#define PG8_WAIT_L(n) asm volatile("s_waitcnt lgkmcnt(" #n ")" ::: "memory")
#define PG8_BAR __builtin_amdgcn_s_barrier()
#define PG8_SCHED __builtin_amdgcn_sched_barrier(0)
    Unit cur, nxt; int ui = 0;
    if (!S.next(0, cur)) return;
    f32x4 acc[2][2][4][2];
#pragma unroll
    for (int a = 0; a < 2; ++a)
#pragma unroll
        for (int b = 0; b < 2; ++b)
#pragma unroll
            for (int m = 0; m < 4; ++m)
#pragma unroll
                for (int n = 0; n < 2; ++n) acc[a][b][m][n] = (f32x4){0.f, 0.f, 0.f, 0.f};
    bf16x8 At[4][2], B0[2][2], B1[2][2];
    const char* cA = (const char*)g.A + (size_t)cur.z * g.sAz + (size_t)cur.pm * tstepA; const char* cB = (const char*)g.Bt + (size_t)cur.z * g.sBz + (size_t)cur.pm * g.sBm + (size_t)cur.pn * tstepB;
    if constexpr (SP2) {
        PG8_STAGE(PG8_SB(0, 0), cB, voffB); PG8_STAGE(PG8_SB(0, 1), cB + hstepB, voffB); PG8_STAGE(PG8_SA(0, 0), cA, voffA); PG8_STAGE(PG8_SA(0, 1), cA + hstepA, voffA);
        if (wr == 1) PG8_BAR;
        PG8_WAIT_V(2); PG8_BAR;
        PG8_STAGE(PG8_SB(1, 0), cB + kstep, voffB); PG8_STAGE(PG8_SA(1, 0), cA + kstep, voffA); PG8_STAGE(PG8_SB(1, 1), cB + hstepB + kstep, voffB);
        PG8_WAIT_V(6); PG8_BAR;
    } else {
        PG8_STAGE(PG8_SB(0, 0), cB, voffB); PG8_STAGE(PG8_SA(0, 0), cA, voffA); PG8_STAGE(PG8_SB(0, 1), cB + hstepB, voffB); PG8_STAGE(PG8_SA(0, 1), cA + hstepA, voffA);
        if (wr == 1) PG8_BAR;
        PG8_WAIT_V(4); PG8_BAR;
        PG8_STAGE(PG8_SB(1, 0), cB + kstep, voffB); PG8_STAGE(PG8_SA(1, 0), cA + kstep, voffA); PG8_STAGE(PG8_SB(1, 1), cB + hstepB + kstep, voffB);
        PG8_WAIT_V(6); PG8_BAR;
    }
    for (;;) {
        const bool has_next = S.next(ui + 1, nxt);
        const char* nA = has_next ? (const char*)g.A + (size_t)nxt.z * g.sAz + (size_t)nxt.pm * tstepA : cA; const char* nB = has_next ? (const char*)g.Bt + (size_t)nxt.z * g.sBz + (size_t)nxt.pm * g.sBm + (size_t)nxt.pn * tstepB : cB;
        for (int t = 0; t < nt; t += 2) {
            const bool last = (t == nt - 2);
            const char* a1 = cA + (size_t)(t + 1) * kstep;
            const char* a2 = last ? nA : cA + (size_t)(t + 2) * kstep; const char* b2 = last ? nB : cB + (size_t)(t + 2) * kstep;
            const char* a3 = a2 + kstep; const char* b3 = b2 + kstep;
            if constexpr (SP2) {
            PG8_LDB(B0, 0, 0); PG8_LDB(B1, 0, 1); PG8_SCHED; PG8_LDA(At, 0, 0); PG8_STAGE(PG8_SA(1, 1), a1 + hstepA, voffA);
            PG8_WAIT_V(8); PG8_WAIT_L(0); PG8_BAR; PG8_MMA(0, 0, At, B0); PG8_MMA(0, 1, At, B1); PG8_BAR; PG8_SCHED;
            PG8_LDA(At, 0, 1); PG8_STAGE(PG8_SB(0, 0), b2, voffB); PG8_STAGE(PG8_SB(0, 1), b2 + hstepB, voffB); PG8_STAGE(PG8_SA(0, 0), a2, voffA);
            PG8_WAIT_V(8); PG8_WAIT_L(0); PG8_BAR; PG8_MMA(1, 0, At, B0); PG8_MMA(1, 1, At, B1); PG8_BAR; PG8_SCHED;
            PG8_LDB(B0, 1, 0); PG8_LDB(B1, 1, 1); PG8_SCHED; PG8_LDA(At, 1, 0); PG8_STAGE(PG8_SA(0, 1), a2 + hstepA, voffA);
            PG8_WAIT_V(8); PG8_WAIT_L(0); PG8_BAR; PG8_MMA(0, 0, At, B0); PG8_MMA(0, 1, At, B1); PG8_BAR; PG8_SCHED;
            PG8_LDA(At, 1, 1); PG8_STAGE(PG8_SB(1, 0), b3, voffB); PG8_STAGE(PG8_SB(1, 1), b3 + hstepB, voffB); PG8_STAGE(PG8_SA(1, 0), a3, voffA);
            PG8_WAIT_V(8); PG8_WAIT_L(0); PG8_BAR; PG8_MMA(1, 0, At, B0); PG8_MMA(1, 1, At, B1); PG8_BAR; PG8_SCHED;
            } else {
            PG8_LDB(B0, 0, 0); PG8_SCHED; PG8_LDA(At, 0, 0); PG8_STAGE(PG8_SA(1, 1), a1 + hstepA, voffA);
            PG8_WAIT_L(8); PG8_BAR; PG8_WAIT_L(0); PG8_MMA(0, 0, At, B0); PG8_BAR; PG8_SCHED;
            PG8_LDB(B1, 0, 1); PG8_STAGE(PG8_SB(0, 0), b2, voffB);
            PG8_BAR; PG8_WAIT_L(0); PG8_MMA(0, 1, At, B1); PG8_BAR;
            PG8_LDA(At, 0, 1); PG8_STAGE(PG8_SA(0, 0), a2, voffA);
            PG8_BAR; PG8_WAIT_L(0); PG8_MMA(1, 0, At, B0); PG8_BAR; PG8_SCHED;
            PG8_STAGE(PG8_SB(0, 1), b2 + hstepB, voffB);
            PG8_WAIT_V(6); PG8_BAR; PG8_MMA(1, 1, At, B1); PG8_BAR;
            PG8_LDB(B0, 1, 0); PG8_SCHED; PG8_LDA(At, 1, 0); PG8_STAGE(PG8_SA(0, 1), a2 + hstepA, voffA);
            PG8_WAIT_L(8); PG8_BAR; PG8_WAIT_L(0); PG8_MMA(0, 0, At, B0); PG8_BAR; PG8_SCHED;
            PG8_LDB(B1, 1, 1); PG8_STAGE(PG8_SB(1, 0), b3, voffB);
            PG8_BAR; PG8_WAIT_L(0); PG8_MMA(0, 1, At, B1); PG8_BAR;
            PG8_LDA(At, 1, 1); PG8_STAGE(PG8_SA(1, 0), a3, voffA);
            PG8_BAR; PG8_WAIT_L(0); PG8_MMA(1, 0, At, B0); PG8_BAR; PG8_SCHED;
            PG8_STAGE(PG8_SB(1, 1), b3 + hstepB, voffB);
            PG8_WAIT_V(6); PG8_BAR; PG8_MMA(1, 1, At, B1); PG8_BAR;
            }
        }
        if constexpr (ALIGN_EPI) { if (wr == 0) PG8_BAR; }
        { int l2; asm volatile("v_mbcnt_lo_u32_b32 %0, -1, 0\n\tv_mbcnt_hi_u32_b32 %0, -1, %0" : "=v"(l2)); E(acc, cur, wr, wc, l2 & 15, l2 >> 4); }
        if (!has_next) break;
#pragma unroll
        for (int a = 0; a < 2; ++a)
#pragma unroll
            for (int b = 0; b < 2; ++b)
#pragma unroll
                for (int m = 0; m < 4; ++m)
#pragma unroll
                    for (int n = 0; n < 2; ++n) acc[a][b][m][n] = (f32x4){0.f, 0.f, 0.f, 0.f};
        cur = nxt; cA = nA; cB = nB; ++ui;
        if constexpr (ALIGN_EPI) { if (wr == 1) PG8_BAR; }
    }
    PG8_WAIT_V(0);
    if constexpr (!ALIGN_EPI) { if (wr == 0) PG8_BAR; }
    PG8_BAR;
#undef PG8_SA
#undef PG8_SB
#undef PG8_STAGE
#undef PG8_LDA
#undef PG8_LDB
#undef PG8_MMA
#undef PG8_WAIT_V
#undef PG8_WAIT_L
#undef PG8_BAR
#undef PG8_SCHED
}
}
namespace att {
using bf16x8 = __attribute__((ext_vector_type(8))) short;
using s16x4  = __attribute__((ext_vector_type(4))) short;
using f32x16 = __attribute__((ext_vector_type(16))) float;
using f32x4v = __attribute__((ext_vector_type(4))) float;
using u32x4  = __attribute__((ext_vector_type(4))) unsigned;
typedef unsigned short bf16_t;
constexpr int NW = 8, QBLK = 32, KVBLK = 64;
constexpr int LDQ = 3072, LDKV = 4096, LDKR = 64, LDO = 2048;
constexpr float SCALE = 0.07216878364870322f;
constexpr float THR = 8.f;
constexpr int SDEPTH = 1;
constexpr int SHM_V = KVBLK * 128 * 2, SHM_KN = KVBLK * 128 * 2, SHM_KR = KVBLK * 64 * 2;
constexpr int OFF_V = 0, OFF_KN = 2 * SHM_V, OFF_KR = OFF_KN + 2 * SHM_KN, OFF_WS = OFF_KR + 2 * SHM_KR, OFF_QR = OFF_WS + NW * 64 * 4, LDS_BYTES = OFF_QR + NW * 4096;
#define KSWZ(row, colB) ((row) * 256 + ((colB) ^ (((row) & 15) << 4)))
#define KRSWZ(row, colB) ((row) * 128 + ((colB) ^ ((((row) >> 1) & 7) << 4)))
#define SBAR() __builtin_amdgcn_sched_barrier(0)
__device__ __forceinline__ int crow(int r, int hi) { return (r & 3) + 8 * (r >> 2) + 4 * hi; }
__device__ __forceinline__ unsigned cvtpk(float lo, float hi) { unsigned r; asm volatile("v_cvt_pk_bf16_f32 %0, %1, %2" : "=v"(r) : "v"(lo), "v"(hi)); return r; }
__device__ __forceinline__ float bf2f(unsigned short b) { return __uint_as_float((unsigned)b << 16); }

constexpr float THRL = THR * 1.4426950408889634f;
template <bool FIRST> __device__ __forceinline__ void partialSM(f32x16& p0, f32x16& p1, float& mhat, f32x16& negm, float& alpha) {
  float pmax = p0[0];
#pragma unroll
  for (int r = 1; r < 16; ++r) pmax = fmaxf(pmax, p0[r]);
#pragma unroll
  for (int r = 0; r < 16; ++r) pmax = fmaxf(pmax, p1[r]);
  { auto rr = __builtin_amdgcn_permlane32_swap(__float_as_uint(pmax), __float_as_uint(pmax), false, false);
    pmax = fmaxf(__uint_as_float(rr[0]), __uint_as_float(rr[1])); }
  alpha = 1.f;
  if (FIRST || !__builtin_expect(__all(pmax <= THRL), 1)) {
    const float dl = FIRST ? pmax : fmaxf(pmax, 0.f); mhat += dl;
#pragma unroll
    for (int r = 0; r < 16; ++r) { p0[r] -= dl; p1[r] -= dl; }
#pragma unroll
    for (int r = 0; r < 16; ++r) negm[r] = -mhat;
    if (!FIRST) alpha = __builtin_amdgcn_exp2f(-dl);
  }
#pragma unroll
  for (int r = 0; r < 16; ++r) p0[r] = __builtin_amdgcn_exp2f(p0[r]);
}
__device__ __forceinline__ void finishSM(f32x16& p0, f32x16& p1, float alpha, float& l_reg, bf16x8& pa0, bf16x8& pa1, bf16x8& pa2, bf16x8& pa3) {
#pragma unroll
  for (int r = 0; r < 16; ++r) p1[r] = __builtin_amdgcn_exp2f(p1[r]);
  float ps = 0;
#pragma unroll
  for (int r = 0; r < 16; ++r) ps += p0[r];
#pragma unroll
  for (int r = 0; r < 16; ++r) ps += p1[r];
  { auto rr = __builtin_amdgcn_permlane32_swap(__float_as_uint(ps), __float_as_uint(ps), false, false);
    ps = __uint_as_float(rr[0]) + __uint_as_float(rr[1]); }
  l_reg = l_reg * alpha + ps;
#define PK4(P, BASE, OUT) do { unsigned a0 = cvtpk(P[BASE + 0], P[BASE + 1]), a1 = cvtpk(P[BASE + 2], P[BASE + 3]);   \
    unsigned b0 = cvtpk(P[BASE + 4], P[BASE + 5]), b1 = cvtpk(P[BASE + 6], P[BASE + 7]);                              \
    auto r0 = __builtin_amdgcn_permlane32_swap(a0, b0, false, false); auto r1 = __builtin_amdgcn_permlane32_swap(a1, b1, false, false); \
    u32x4 w = {r0[0], r1[0], r0[1], r1[1]}; OUT = *reinterpret_cast<bf16x8*>(&w); } while (0)
  PK4(p0, 0, pa0); PK4(p0, 8, pa1); PK4(p1, 0, pa2); PK4(p1, 8, pa3);
#undef PK4
}
__device__ __forceinline__ void qkt(f32x16& p0, f32x16& p1, const char* Kn, const char* Kr, const bf16x8* qr, const char* qrl, const f32x16& negm, int r32, int hi) {
  p0 = negm; p1 = negm;
#pragma unroll
  for (int d0 = 0; d0 < 8; ++d0) { const int cb = (d0 * 16 + hi * 8) * 2;
    bf16x8 b0 = *reinterpret_cast<const bf16x8*>(Kn + KSWZ(r32, cb));
    bf16x8 b1 = *reinterpret_cast<const bf16x8*>(Kn + KSWZ(32 + r32, cb));
    p0 = __builtin_amdgcn_mfma_f32_32x32x16_bf16(b0, qr[d0], p0, 0, 0, 0);
    p1 = __builtin_amdgcn_mfma_f32_32x32x16_bf16(b1, qr[d0], p1, 0, 0, 0); }
#pragma unroll
  for (int d0 = 0; d0 < 4; ++d0) { const int cb = (d0 * 16 + hi * 8) * 2;
    bf16x8 b0 = *reinterpret_cast<const bf16x8*>(Kr + KRSWZ(r32, cb));
    bf16x8 b1 = *reinterpret_cast<const bf16x8*>(Kr + KRSWZ(32 + r32, cb));
    const bf16x8 qv = *reinterpret_cast<const bf16x8*>(qrl + d0 * 1024);
    p0 = __builtin_amdgcn_mfma_f32_32x32x16_bf16(b0, qv, p0, 0, 0, 0);
    p1 = __builtin_amdgcn_mfma_f32_32x32x16_bf16(b1, qv, p1, 0, 0, 0); }
}
__device__ __forceinline__ int v_st(int k, int c) { const int kk = (k & ~0xC) | ((k & 4) << 1) | ((k & 8) >> 1); return ((kk >> 3) * 4 + (c >> 5)) * 512 + ((kk & 7) * 32 + (c & 31)) * 2; }
__device__ __forceinline__ int v_rd_base(int lane) { return ((lane & 3) << 3) | (((lane >> 2) & 3) << 6) | (((lane >> 4) & 1) << 5) | (((lane >> 5) & 1) << 8); }
constexpr int v_rd_off(int d0, int ks, int half) { return d0 * 512 + ks * 4096 + half * 2048; }
template <int OFF> __device__ __forceinline__ s16x4 tr_read(int vb) {
  s16x4 r; asm volatile("ds_read_b64_tr_b16 %0, %1 offset:%2" : "=&v"(r) : "v"(vb), "i"(OFF) : "memory"); return r;
}
template <int D0> __device__ __forceinline__ void pv_one(f32x16& od, int vb, bf16x8 pa0, bf16x8 pa1, bf16x8 pa2, bf16x8 pa3) {
  const s16x4 l0 = tr_read<v_rd_off(D0, 0, 0)>(vb), h0 = tr_read<v_rd_off(D0, 0, 1)>(vb), l1 = tr_read<v_rd_off(D0, 1, 0)>(vb), h1 = tr_read<v_rd_off(D0, 1, 1)>(vb);
  const s16x4 l2 = tr_read<v_rd_off(D0, 2, 0)>(vb), h2 = tr_read<v_rd_off(D0, 2, 1)>(vb), l3 = tr_read<v_rd_off(D0, 3, 0)>(vb), h3 = tr_read<v_rd_off(D0, 3, 1)>(vb);
  asm volatile("s_waitcnt lgkmcnt(0)" ::: "memory"); SBAR();
#define PK(L, H) (bf16x8){L[0], L[1], L[2], L[3], H[0], H[1], H[2], H[3]}
  od = __builtin_amdgcn_mfma_f32_32x32x16_bf16(pa0, PK(l0, h0), od, 0, 0, 0);
  od = __builtin_amdgcn_mfma_f32_32x32x16_bf16(pa1, PK(l1, h1), od, 0, 0, 0);
  od = __builtin_amdgcn_mfma_f32_32x32x16_bf16(pa2, PK(l2, h2), od, 0, 0, 0);
  od = __builtin_amdgcn_mfma_f32_32x32x16_bf16(pa3, PK(l3, h3), od, 0, 0, 0);
#undef PK
}
__device__ __forceinline__ void pv_d0(f32x16* o, int vb, bf16x8 pa0, bf16x8 pa1, bf16x8 pa2, bf16x8 pa3) {
  pv_one<0>(o[0], vb, pa0, pa1, pa2, pa3); pv_one<1>(o[1], vb, pa0, pa1, pa2, pa3); pv_one<2>(o[2], vb, pa0, pa1, pa2, pa3); pv_one<3>(o[3], vb, pa0, pa1, pa2, pa3);
}

constexpr int RK = 3 * (SHM_KN + SHM_KR), RV = 3 * SHM_V;
constexpr int D_OFF_K = 0, D_OFF_V = RK, D_OFF_WS = RK + RV, D_OFF_QR = D_OFF_WS + NW * 64 * 4  , D_LDS_BYTES = D_OFF_QR + NW * 4096;
__device__ __forceinline__ void attn_unit(const bf16_t* __restrict__ Qb, const bf16_t* __restrict__ Kn, const bf16_t* __restrict__ Vh, const bf16_t* __restrict__ Kr,
                                          bf16_t* __restrict__ Ob, const float* __restrict__ rope, int pos0, int seq, char* lds, int wid  ) {
  typedef __attribute__((address_space(3))) unsigned las_u32;
  int lane; asm volatile("v_mbcnt_lo_u32_b32 %0, -1, 0\n\tv_mbcnt_hi_u32_b32 %0, -1, %0" : "=v"(lane));
  const int r32 = lane & 31, hi = lane >> 5;
  float* ws = (float*)(lds + D_OFF_WS) + wid * 64; float* li_l = ws; float* al_l = ws + 32;
  float mhat = 0.f, l_reg = 0; f32x16 o[4] = {}; bf16x8 qr[12]; f32x16 negm = f32x16{};
  constexpr float CQ = SCALE * 1.4426950408889634f;
  const bf16_t* Qw = Qb + (long)(wid * QBLK + r32) * LDQ + hi * 8;
#pragma unroll
  for (int d0 = 0; d0 < 12; ++d0) qr[d0] = *reinterpret_cast<const bf16x8*>(Qw + d0 * 16);
#pragma unroll
  for (int d0 = 0; d0 < 12; ++d0) if (d0 < 8 || !rope) { bf16x8 q = qr[d0]; u32x4 w;
    w.x = cvtpk(bf2f((unsigned short)q[0]) * CQ, bf2f((unsigned short)q[1]) * CQ); w.y = cvtpk(bf2f((unsigned short)q[2]) * CQ, bf2f((unsigned short)q[3]) * CQ);
    w.z = cvtpk(bf2f((unsigned short)q[4]) * CQ, bf2f((unsigned short)q[5]) * CQ); w.w = cvtpk(bf2f((unsigned short)q[6]) * CQ, bf2f((unsigned short)q[7]) * CQ);
    qr[d0] = *reinterpret_cast<bf16x8*>(&w); }
  if (rope) {
    const float* rp = rope + (long)(pos0 + wid * QBLK + r32) * 64;
#pragma unroll
    for (int d0 = 0; d0 < 4; ++d0) {
      const int p0i = d0 * 8 + hi * 4;
      const f32x4v c0 = *reinterpret_cast<const f32x4v*>(rp + p0i * 2), c1 = *reinterpret_cast<const f32x4v*>(rp + p0i * 2 + 4);
      bf16x8 q = qr[8 + d0];
      const float a0 = bf2f((unsigned short)q[0]) * CQ, b0 = bf2f((unsigned short)q[1]) * CQ, a1 = bf2f((unsigned short)q[2]) * CQ, b1 = bf2f((unsigned short)q[3]) * CQ;
      const float a2 = bf2f((unsigned short)q[4]) * CQ, b2 = bf2f((unsigned short)q[5]) * CQ, a3 = bf2f((unsigned short)q[6]) * CQ, b3 = bf2f((unsigned short)q[7]) * CQ;
      u32x4 w;
      w.x = cvtpk(a0 * c0[0] - b0 * c0[1], b0 * c0[0] + a0 * c0[1]);
      w.y = cvtpk(a1 * c0[2] - b1 * c0[3], b1 * c0[2] + a1 * c0[3]);
      w.z = cvtpk(a2 * c1[0] - b2 * c1[1], b2 * c1[0] + a2 * c1[1]);
      w.w = cvtpk(a3 * c1[2] - b3 * c1[3], b3 * c1[2] + a3 * c1[3]);
      qr[8 + d0] = *reinterpret_cast<bf16x8*>(&w);
    }
  }
  char* qrl = lds + D_OFF_QR + wid * 4096 + lane * 16;
#pragma unroll
  for (int d0 = 0; d0 < 4; ++d0) *reinterpret_cast<bf16x8*>(qrl + d0 * 1024) = qr[8 + d0];
  unsigned gkn[2], gv[2], gkr;
#pragma unroll
  for (int i = 0; i < 2; ++i) {
    const int c = 2 * wid + i;
    { const int row = 4 * c + (lane >> 4), colB = ((lane & 15) * 16) ^ ((row & 15) << 4); gkn[i] = (unsigned)(row * LDKV + (colB >> 1)) * 2u; }
    { const int sub = 2 * c + (lane >> 5), kk = (sub >> 2) * 8 + ((lane & 31) >> 2), key = (kk & ~0xC) | ((kk & 4) << 1) | ((kk & 8) >> 1), col = (sub & 3) * 32 + (lane & 3) * 8; gv[i] = (unsigned)(key * LDKV + col) * 2u; }
  }
  { const int row = 8 * wid + (lane >> 3), colB = ((lane & 7) * 16) ^ (((row >> 1) & 7) << 4); gkr = (unsigned)(row * LDKR + (colB >> 1)) * 2u; }
  char* Kring = lds + D_OFF_K; char* Vring = lds + D_OFF_V;
#define DMA16(gp, lp) __builtin_amdgcn_global_load_lds((const unsigned*)(gp), (las_u32*)(lp), 16, 0, 0)
#define ISSUE_K(t, slot) do { const bf16_t* kb_ = Kn + (long)(t) * KVBLK * LDKV; const bf16_t* rb_ = Kr + (long)(t) * KVBLK * LDKR; asm volatile("" : "+s"(kb_), "+s"(rb_)); char* d_ = Kring + (slot) * (SHM_KN + SHM_KR); \
    asm volatile("" : "+v"(gkn[0]), "+v"(gkn[1]), "+v"(gkr));     \
    DMA16((const char*)kb_ + gkn[0], d_ + (2 * wid) * 1024); DMA16((const char*)kb_ + gkn[1], d_ + (2 * wid + 1) * 1024); DMA16((const char*)rb_ + gkr, d_ + SHM_KN + wid * 1024); } while (0)
#define ISSUE_V(t, slot) do { const bf16_t* vb_ = Vh + (long)(t) * KVBLK * LDKV; asm volatile("" : "+s"(vb_)); char* d_ = Vring + (slot) * SHM_V; \
    asm volatile("" : "+v"(gv[0]), "+v"(gv[1])); \
    DMA16((const char*)vb_ + gv[0], d_ + (2 * wid) * 1024); DMA16((const char*)vb_ + gv[1], d_ + (2 * wid + 1) * 1024); } while (0)
#define WAITV(n) asm volatile("s_waitcnt vmcnt(" #n ")" ::: "memory")
#define BARRIER() do { asm volatile("" ::: "memory"); __builtin_amdgcn_s_barrier(); asm volatile("" ::: "memory"); } while (0)
#define RESC(a) do { if (__any((a) < 1.f)) { if (hi == 0) al_l[r32] = (a); asm volatile("s_waitcnt lgkmcnt(0)" ::: "memory"); \
    _Pragma("unroll") for (int d = 0; d < 4; ++d) _Pragma("unroll") for (int r = 0; r < 16; ++r) o[d][r] *= al_l[crow(r, hi)]; } } while (0)
  const int vb0 = (int)(uintptr_t)Vring + v_rd_base(lane);
  f32x16 pA0, pA1, pB0, pB1; float alA, alB; bf16x8 pa0, pa1, pa2, pa3; const int NT = seq / KVBLK;
  int s_cur = 0, s_nxt = 1, s_prv = 2;
#define ROT() do { const int t_ = s_prv; s_prv = s_cur; s_cur = s_nxt; s_nxt = t_; } while (0)
  if (wid >= 4) __builtin_amdgcn_s_setprio(1);
  WAITV(0);
  ISSUE_K(0, 0);
  ISSUE_K(1, 1); ISSUE_V(0, 0);
  WAITV(5); BARRIER();
  if (2 < NT) ISSUE_K(2, 2);
  ISSUE_V(1, 1);
  qkt(pA0, pA1, Kring, Kring + SHM_KN, qr, qrl, negm, r32, hi); partialSM<true>(pA0, pA1, mhat, negm, alA);
  ROT();
  for (int j = 1; j + 1 < NT; j += 2) {
    WAITV(5); BARRIER();
    if (j + 2 < NT) ISSUE_K(j + 2, s_prv);
    ISSUE_V(j + 1, s_nxt);
    SBAR(); qkt(pB0, pB1, Kring + s_cur * (SHM_KN + SHM_KR), Kring + s_cur * (SHM_KN + SHM_KR) + SHM_KN, qr, qrl, negm, r32, hi);
    finishSM(pA0, pA1, alA, l_reg, pa0, pa1, pa2, pa3); SBAR();
    pv_d0(o, vb0 + s_prv * SHM_V, pa0, pa1, pa2, pa3); partialSM<false>(pB0, pB1, mhat, negm, alB);
    RESC(alB);
    ROT();
    WAITV(5); BARRIER();
    if (j + 3 < NT) ISSUE_K(j + 3, s_prv);
    ISSUE_V(j + 2, s_nxt);
    SBAR(); qkt(pA0, pA1, Kring + s_cur * (SHM_KN + SHM_KR), Kring + s_cur * (SHM_KN + SHM_KR) + SHM_KN, qr, qrl, negm, r32, hi);
    finishSM(pB0, pB1, alB, l_reg, pa0, pa1, pa2, pa3); SBAR();
    pv_d0(o, vb0 + s_prv * SHM_V, pa0, pa1, pa2, pa3); partialSM<false>(pA0, pA1, mhat, negm, alA);
    RESC(alA);
    ROT();
  }
  WAITV(2); BARRIER();
  SBAR(); qkt(pB0, pB1, Kring + s_cur * (SHM_KN + SHM_KR), Kring + s_cur * (SHM_KN + SHM_KR) + SHM_KN, qr, qrl, negm, r32, hi);
  finishSM(pA0, pA1, alA, l_reg, pa0, pa1, pa2, pa3); SBAR();
  pv_d0(o, vb0 + s_prv * SHM_V, pa0, pa1, pa2, pa3); partialSM<false>(pB0, pB1, mhat, negm, alB);
  RESC(alB);
  WAITV(0); BARRIER();
  finishSM(pB0, pB1, alB, l_reg, pa0, pa1, pa2, pa3); SBAR();
  pv_d0(o, vb0 + s_cur * SHM_V, pa0, pa1, pa2, pa3);
  __builtin_amdgcn_s_setprio(0);
  if (hi == 0) li_l[r32] = l_reg; asm volatile("s_waitcnt lgkmcnt(0)" ::: "memory");
  float rli[16];
#pragma unroll
  for (int r = 0; r < 16; ++r) rli[r] = __builtin_amdgcn_rcpf(li_l[crow(r, hi)]);
  bf16_t* Ow = Ob + (long)(wid * QBLK) * LDO;
#pragma unroll
  for (int r = 0; r < 16; ++r) { const int orow = crow(r, hi);
#pragma unroll
    for (int d0 = 0; d0 < 4; ++d0) { const float v = o[d0][r] * rli[r]; Ow[(long)orow * LDO + d0 * 32 + r32] = (bf16_t)(cvtpk(v, v) & 0xffffu); } }
  asm volatile("s_waitcnt lgkmcnt(0)" ::: "memory"); BARRIER();
#undef DMA16
#undef ISSUE_K
#undef ISSUE_V
#undef WAITV
#undef BARRIER
#undef RESC
#undef ROT
}
#undef KSWZ
#undef KRSWZ
#undef SBAR
}
constexpr int NWAVES = 8;
constexpr int DM = 2048, SEQ = 8192, CTXL = 256, T = SEQ + CTXL  , DEPTH = 4;
constexpr int NH = 16, QL = 512, KVL = 512, DNOPE = 128, DROPE = 64, DV = 128;
constexpr int NDQ = QL + KVL + DROPE  , NDQP = 1280  , NUQ = NH * (DNOPE + DROPE)  , NUKV = NH * (DNOPE + DV)  ;
constexpr int DFF = 5632, NUP = 2 * DFF  ;
constexpr int NMOD = 6;
constexpr float NORM_EPS = 1e-6f;
constexpr int GC = 256  , NG = 8;

constexpr size_t MiB = 1u << 20;
constexpr size_t WS_CTL = 0, CTL_ZERO_BYTES = 1 * MiB;
constexpr size_t WS_MOD = 1 * MiB;
constexpr size_t WS_ROPE = 2 * MiB;
constexpr size_t WS_WCT = 4 * MiB;
constexpr size_t WS_WCT4 = 6 * MiB;
constexpr size_t WS_DSC = 5 * MiB;
constexpr size_t WS_WDQ = 8 * MiB;
constexpr size_t WS_WUQ = 18 * MiB;
constexpr size_t WS_WUKV = 24 * MiB;
constexpr size_t WS_WO = 32 * MiB;
constexpr size_t WS_WFNO = 48 * MiB;
constexpr size_t WS_WUP = 64 * MiB;
constexpr size_t WS_WDN = 240 * MiB;
constexpr size_t WS_DS = 384 * MiB;
constexpr size_t WS_XS = 640 * MiB;
constexpr size_t WS_HN = 720 * MiB;
constexpr size_t WS_SSQ = 760 * MiB;
constexpr size_t WS_CQN = 808 * MiB;
constexpr size_t WS_CKVN = 820 * MiB;
constexpr size_t WS_KR = 832 * MiB;
constexpr size_t WS_Q = 840 * MiB;
constexpr size_t WS_KV = 896 * MiB;
constexpr size_t WS_O = 968 * MiB;
constexpr size_t WS_U = 1008 * MiB;
constexpr size_t WS_ACT = 1192 * MiB;
constexpr size_t WS_YT = 1288 * MiB;
constexpr size_t WS_YTC = 1352 * MiB;
constexpr size_t WS_PART = 1356 * MiB;
constexpr size_t WS_PQ = 1380 * MiB;
constexpr size_t WS_H4 = 1412 * MiB;
constexpr size_t WS_V1 = 1413 * MiB;
constexpr size_t WS_U2C = 1414 * MiB;
constexpr size_t WS_EDGE = 330 * MiB;
constexpr size_t WS_CWS = 338 * MiB;
constexpr size_t WS_END = 1430 * MiB;
constexpr int CW_BAR = 4096;

constexpr int RING_OFF = 0, RING_BYTES = 131072;
constexpr int XCH_OFF = 131072;
constexpr int LDSCTL_OFF = 158720, MISC_OFF = LDSCTL_OFF + 320;
constexpr int LDS_BYTES = 163840;

#define GAS __attribute__((address_space(1)))
#define LAS __attribute__((address_space(3)))
typedef unsigned short bf16;
typedef unsigned v4u __attribute__((ext_vector_type(4)));
typedef unsigned v2u __attribute__((ext_vector_type(2)));
typedef float f32x4 __attribute__((ext_vector_type(4)));
typedef GAS unsigned gu32;
#define LDS_WAIT() asm volatile("s_waitcnt lgkmcnt(0)" ::: "memory")
#define VM_WAIT() asm volatile("s_waitcnt vmcnt(0)" ::: "memory")
__device__ __forceinline__ unsigned f2bf(float f) { unsigned u = __builtin_bit_cast(unsigned, f); return (u + 0x7fffu + ((u >> 16) & 1u)) >> 16; }
__device__ __forceinline__ unsigned pk2(float lo, float hi) { return f2bf(lo) | (f2bf(hi) << 16); }
__device__ __forceinline__ float bflo(unsigned w) { return __uint_as_float(w << 16); }
__device__ __forceinline__ float bfhi(unsigned w) { return __uint_as_float(w & 0xffff0000u); }
__device__ __forceinline__ float silu_f(float v) { return v / (1.f + __expf(-v)); }

#define XB_TMO      128
#define XB_XCNT(j)  (256  + 64 * (j))
#define XB_XSUB(j)  (1280 + 64 * (j))
#define XB_XGEN(j)  (2304 + 64 * (j))
#define XB_TOP      3328
#define XB_TOPGEN   3392
#define XCD_BAR_WORDS 3456
#define XB_SPIN_CAP (1u << 18)
__device__ __forceinline__ unsigned xb_ld(unsigned* p)              { return __hip_atomic_load(p, __ATOMIC_RELAXED, __HIP_MEMORY_SCOPE_AGENT); }
__device__ __forceinline__ unsigned xb_add(unsigned* p, unsigned v) { return __hip_atomic_fetch_add(p, v, __ATOMIC_RELAXED, __HIP_MEMORY_SCOPE_AGENT); }
__device__ __forceinline__ unsigned xb_xcc_id() { return (unsigned)__builtin_amdgcn_s_getreg((3 << 11) | 20) & 0xFu; }
#define XB_SPIN(cond, bar) do { unsigned _sp = 0; while (cond) { __builtin_amdgcn_s_sleep(1); \
    if ((++_sp & 255u) == 0u) { if (xb_ld(&(bar)[XB_TMO])) break; if (_sp > XB_SPIN_CAP) { atomicAdd(&(bar)[XB_TMO], 1u); break; } } } } while (0)
struct XcdBarrier { unsigned* bar; unsigned x; volatile LAS unsigned* st; };
__device__ __forceinline__ XcdBarrier xcd_barrier_post(unsigned* bar, volatile LAS unsigned* st) {
    XcdBarrier b; b.bar = bar; b.x = xb_xcc_id(); b.st = st;
    if (threadIdx.x == 0) (void)xb_add(&bar[XB_XCNT(b.x)], 1u);
    return b;
}
__device__ __forceinline__ void xcd_barrier_complete(unsigned* bar, unsigned x, unsigned& nloc, unsigned& nx) {
    const unsigned G = gridDim.x * gridDim.y * gridDim.z;
    unsigned sum, cnt, mine, sp = 0u;
    for (;;) {
        sum = 0u; cnt = 0u; mine = 0u;
#pragma unroll
        for (unsigned j = 0; j < 16; ++j) { const unsigned c = xb_ld(&bar[XB_XCNT(j)]); sum += c; cnt += (c > 0u) ? 1u : 0u; mine = (j == x) ? c : mine; }
        if (sum == G) break;
        __builtin_amdgcn_s_sleep(1);
        if ((++sp & 255u) == 0u) { if (xb_ld(&bar[XB_TMO])) break; if (sp > XB_SPIN_CAP) { atomicAdd(&bar[XB_TMO], 1u); break; } }
    }
    nloc = mine > 0u ? mine : 1u; nx = cnt > 0u ? cnt : 1u;
}
__device__ __forceinline__ void xcd_barrier(const XcdBarrier& b) {
    asm volatile("s_waitcnt vmcnt(0)" ::: "memory");
    __syncthreads();
    if (threadIdx.x == 0) {
        unsigned* bar = b.bar; unsigned bx_ = b.x; asm volatile("" : "+s"(bar), "+s"(bx_));
        __builtin_amdgcn_s_waitcnt(0);
        unsigned nloc = b.st[0], nx = b.st[1];
        if (nloc == 0u) { xcd_barrier_complete(bar, bx_, nloc, nx); b.st[0] = nloc; b.st[1] = nx; }
        const unsigned old = xb_add(&bar[XB_XSUB(bx_)], 1u);
        const unsigned gen = old / nloc;
        if (old + 1u == (gen + 1u) * nloc) {
            __builtin_amdgcn_fence(__ATOMIC_RELEASE, "agent");
            asm volatile("s_waitcnt vmcnt(0)" ::: "memory");
            const unsigned og = xb_add(&bar[XB_TOP], 1u);
            const unsigned tg = og / nx;
            if (og + 1u == (tg + 1u) * nx) xb_add(&bar[XB_TOPGEN], 1u);
            else XB_SPIN(xb_ld(&bar[XB_TOPGEN]) == tg, bar);
            __builtin_amdgcn_fence(__ATOMIC_ACQUIRE, "agent");
            xb_add(&bar[XB_XGEN(bx_)], 1u);
            asm volatile("s_waitcnt vmcnt(0)" ::: "memory");
        } else {
            XB_SPIN(xb_ld(&bar[XB_XGEN(bx_)]) == gen, bar);
            __builtin_amdgcn_fence(__ATOMIC_ACQUIRE, "agent");
            asm volatile("s_waitcnt vmcnt(0)" ::: "memory");
        }
    }
    __syncthreads();
}

__device__ __forceinline__ int lane_id_opaque() { int lane; asm volatile("v_mbcnt_lo_u32_b32 %0, -1, 0\n\tv_mbcnt_hi_u32_b32 %0, -1, %0" : "=v"(lane)); return lane; }
__device__ __forceinline__ float wave_sum(float v, int lane) {
#pragma unroll
    for (int o = 1; o < 64; o <<= 1) v += __builtin_bit_cast(float, __builtin_amdgcn_ds_bpermute((lane ^ o) << 2, __builtin_bit_cast(int, v)));
    return v;
}

template <int MODE> __device__ __forceinline__ int dest_row(int n) {
    if (MODE == 1) {
        const int h = n / 192, c = n - h * 192; if (c < 128) return n;
        const int e = c - 128, half = e >> 5, second = (e >> 4) & 1, j = e & 15; return h * 192 + 128 + 2 * (half * 16 + j) + second;
    } else if (MODE == 2) {
        const int g = n >= DFF ? 1 : 0, c = n - g * DFF, t = c >> 7, i = c & 127; return t * 256 + g * 128 + i;
    } else if (MODE == 3) {
        if (n < QL + KVL) return n;
        const int e = n - (QL + KVL), half = e >> 5, second = (e >> 4) & 1, j = e & 15; return QL + KVL + 2 * (half * 16 + j) + second;
    }
    return n;
}
template <int MODE> __device__ __forceinline__ void p0_transpose_item(const float* W, int K, int N, bf16* WT, LAS float* scr, int item, int lane, const float* ks = nullptr) {
    const int nblk = N / 32, i8 = item >> 3, kb = (i8 / nblk) * 8 + (item & 7), nb = i8 % nblk, k0 = 64 * kb, n0 = 32 * nb;
    { f32x4 w[8]; const int c4 = (lane & 7) * 4;
#pragma unroll
      for (int i = 0; i < 8; ++i) w[i] = *(const GAS f32x4*)(W + (size_t)(k0 + 8 * i + (lane >> 3)) * N + n0 + c4);
#pragma unroll
      for (int i = 0; i < 8; ++i) { LAS float* d = scr + (8 * i + (lane >> 3)) * 33 + c4; d[0] = w[i].x; d[1] = w[i].y; d[2] = w[i].z; d[3] = w[i].w; } }
    LDS_WAIT(); asm volatile("" ::: "memory");
    const int c = lane & 7;
    float kq[8];
#pragma unroll
    for (int i = 0; i < 8; ++i) kq[i] = ks ? ks[k0 + 8 * c + i] : 1.0f;
#pragma unroll
    for (int j = 0; j < 4; ++j) { const int n = (lane >> 3) + 8 * j; const LAS float* s = scr + (8 * c) * 33 + n;
        v4u o; o.x = pk2(s[0 * 33] * kq[0], s[1 * 33] * kq[1]); o.y = pk2(s[2 * 33] * kq[2], s[3 * 33] * kq[3]); o.z = pk2(s[4 * 33] * kq[4], s[5 * 33] * kq[5]); o.w = pk2(s[6 * 33] * kq[6], s[7 * 33] * kq[7]);
        *(GAS v4u*)(WT + (size_t)dest_row<MODE>(n0 + n) * K + k0 + 8 * c) = o; }
    LDS_WAIT(); asm volatile("" ::: "memory");
}
__device__ __forceinline__ void unpack8(const v4u w, float (&f)[8]) {
#pragma unroll
    for (int e = 0; e < 4; ++e) { f[2 * e] = bflo(w[e]); f[2 * e + 1] = bfhi(w[e]); }
}
__device__ __forceinline__ v4u pack8(const float (&f)[8]) { v4u w; w.x = pk2(f[0], f[1]); w.y = pk2(f[2], f[3]); w.z = pk2(f[4], f[5]); w.w = pk2(f[6], f[7]); return w; }
__device__ __forceinline__ void norm_rows(int gw, int NGW, int row_lo, int row_hi, bf16* xs, bool xs_in, const float* xin, const float* ctxin,
                                          const float* g, const float* modx, const float* modc, int shi, int sci, bf16* HN, const float* part, int npart) {
    const int lane = lane_id_opaque(); asm volatile("" : "+s"(gw), "+s"(NGW));
    for (int row = row_lo + gw; row < row_hi; row += NGW) {
        const float* mod = row < CTXL ? modc : modx;
        float v[4][8]; float ss = 0.f; bool wb = false;
        if (xs_in) {
#pragma unroll
            for (int j = 0; j < 4; ++j) unpack8(*(const GAS v4u*)(xs + (size_t)row * DM + lane * 8 + 512 * j), v[j]);
        } else { const float* src = row < CTXL ? ctxin + (size_t)row * DM : xin + (size_t)(row - CTXL) * DM; wb = true;
#pragma unroll
            for (int j = 0; j < 4; ++j) { const f32x4 a = *(const GAS f32x4*)(src + lane * 8 + 512 * j), c = *(const GAS f32x4*)(src + lane * 8 + 512 * j + 4);
                v[j][0] = a.x; v[j][1] = a.y; v[j][2] = a.z; v[j][3] = a.w; v[j][4] = c.x; v[j][5] = c.y; v[j][6] = c.z; v[j][7] = c.w; }
        }
        if (row < CTXL && npart > 0) {
            for (int z = 0; z < npart; ++z) { const float* pr = part + ((size_t)z * CTXL + row) * DM + lane * 8;
#pragma unroll
                for (int j = 0; j < 4; ++j) { const f32x4 a = *(const GAS f32x4*)(pr + 512 * j), c = *(const GAS f32x4*)(pr + 512 * j + 4);
                    v[j][0] += a.x; v[j][1] += a.y; v[j][2] += a.z; v[j][3] += a.w; v[j][4] += c.x; v[j][5] += c.y; v[j][6] += c.z; v[j][7] += c.w; } }
            wb = true;
        }
        if (wb) {
#pragma unroll
            for (int j = 0; j < 4; ++j) *(GAS v4u*)(xs + (size_t)row * DM + lane * 8 + 512 * j) = pack8(v[j]);
        }
#pragma unroll
        for (int j = 0; j < 4; ++j)
#pragma unroll
            for (int e = 0; e < 8; ++e) ss += v[j][e] * v[j][e];
        const float rstd = 1.0f / sqrtf(wave_sum(ss, lane) * (1.f / DM) + NORM_EPS);
#pragma unroll
        for (int j = 0; j < 4; ++j) { const int c = lane * 8 + 512 * j; float gq[8], sq[8], hq[8], y[8];
            { const f32x4 a = *(const GAS f32x4*)(g + c), b_ = *(const GAS f32x4*)(g + c + 4); gq[0] = a.x; gq[1] = a.y; gq[2] = a.z; gq[3] = a.w; gq[4] = b_.x; gq[5] = b_.y; gq[6] = b_.z; gq[7] = b_.w; }
            { const f32x4 a = *(const GAS f32x4*)(mod + sci * DM + c), b_ = *(const GAS f32x4*)(mod + sci * DM + c + 4); sq[0] = a.x; sq[1] = a.y; sq[2] = a.z; sq[3] = a.w; sq[4] = b_.x; sq[5] = b_.y; sq[6] = b_.z; sq[7] = b_.w; }
            { const f32x4 a = *(const GAS f32x4*)(mod + shi * DM + c), b_ = *(const GAS f32x4*)(mod + shi * DM + c + 4); hq[0] = a.x; hq[1] = a.y; hq[2] = a.z; hq[3] = a.w; hq[4] = b_.x; hq[5] = b_.y; hq[6] = b_.z; hq[7] = b_.w; }
#pragma unroll
            for (int e = 0; e < 8; ++e) y[e] = (v[j][e] * rstd) * gq[e] * (sq[e] + 1.0f) + hq[e];
            *(GAS v4u*)(HN + (size_t)row * DM + c) = pack8(y); }
    }
}
__device__ __forceinline__ void norm_ctx_wg(int vcu, int G, int wave, LAS float* red, bf16* xs, bool xs_in, const float* ctxin, const float* g, const float* modc, int shi, int sci, bf16* HN, const float* part, int npart) {
    const int lane = lane_id_opaque(); asm volatile("" : "+s"(vcu), "+s"(G));
    for (int r = vcu; r < CTXL; r += G) {
        const int c = wave * 256 + lane * 4; float v[4];
        if (xs_in) { const v2u w = *(const GAS v2u*)(xs + (size_t)r * DM + c); v[0] = bflo(w.x); v[1] = bfhi(w.x); v[2] = bflo(w.y); v[3] = bfhi(w.y); }
        else { const f32x4 a = *(const GAS f32x4*)(ctxin + (size_t)r * DM + c); v[0] = a.x; v[1] = a.y; v[2] = a.z; v[3] = a.w; }
        { f32x4 pp[11];
#pragma unroll
          for (int z = 0; z < 11; ++z) if (z < npart) pp[z] = *(const GAS f32x4*)(part + ((size_t)z * CTXL + r) * DM + c);
#pragma unroll
          for (int z = 0; z < 11; ++z) if (z < npart) { v[0] += pp[z].x; v[1] += pp[z].y; v[2] += pp[z].z; v[3] += pp[z].w; } }
        if (!xs_in || npart > 0) { v2u w; w.x = pk2(v[0], v[1]); w.y = pk2(v[2], v[3]); *(GAS v2u*)(xs + (size_t)r * DM + c) = w; }
        const float ss = wave_sum((v[0] * v[0] + v[1] * v[1]) + (v[2] * v[2] + v[3] * v[3]), lane);
        if (lane == 0) red[wave] = ss;
        __syncthreads();
        float tot = 0.f;
#pragma unroll
        for (int w8 = 0; w8 < NWAVES; ++w8) tot += red[w8];
        const float rstd = 1.0f / sqrtf(tot * (1.f / DM) + NORM_EPS);
        const f32x4 g4 = *(const GAS f32x4*)(g + c), sc4 = *(const GAS f32x4*)(modc + sci * DM + c), sh4 = *(const GAS f32x4*)(modc + shi * DM + c);
        v2u o; o.x = pk2(v[0] * rstd * g4.x * (sc4.x + 1.f) + sh4.x, v[1] * rstd * g4.y * (sc4.y + 1.f) + sh4.y); o.y = pk2(v[2] * rstd * g4.z * (sc4.z + 1.f) + sh4.z, v[3] * rstd * g4.w * (sc4.w + 1.f) + sh4.w);
        *(GAS v2u*)(HN + (size_t)r * DM + c) = o;
        __syncthreads();
    }
}
__device__ __forceinline__ void norm_quad_rows(int gw, int NGW, const bf16* xs, const float* g, const float* modx, int shi, int sci, bf16* HQ, float* HV) {
    const int lane = lane_id_opaque(); asm volatile("" : "+s"(gw), "+s"(NGW));
    constexpr int Q4 = SEQ / 4, H2 = SEQ / 2;
    for (int n = gw; n < Q4; n += NGW) {
        const int ra = n, rb = n == 0 ? Q4 : H2 - n, rc = H2 + n, rd = n == 0 ? H2 + Q4 : SEQ - n;
        v4u raw[4][4]; float rs[4];
#pragma unroll
        for (int q = 0; q < 4; ++q) { const int r = q == 0 ? ra : q == 1 ? rb : q == 2 ? rc : rd;
#pragma unroll
            for (int j = 0; j < 4; ++j) raw[q][j] = *(const GAS v4u*)(xs + (size_t)(CTXL + r) * DM + lane * 8 + 512 * j); }
#pragma unroll
        for (int q = 0; q < 4; ++q) { float ss = 0.f;
#pragma unroll
            for (int j = 0; j < 4; ++j)
#pragma unroll
                for (int e = 0; e < 4; ++e) { const float l_ = bflo(raw[q][j][e]), h_ = bfhi(raw[q][j][e]); ss += l_ * l_ + h_ * h_; }
            rs[q] = ss; }
#pragma unroll
        for (int q = 0; q < 4; ++q)
#pragma unroll
            for (int j = 0; j < 4; ++j) asm volatile("" : "+v"(raw[q][j]));
#pragma unroll
        for (int o = 1; o < 64; o <<= 1)
#pragma unroll
            for (int q = 0; q < 4; ++q) rs[q] += __builtin_bit_cast(float, __builtin_amdgcn_ds_bpermute((lane ^ o) << 2, __builtin_bit_cast(int, rs[q])));
#pragma unroll
        for (int q = 0; q < 4; ++q) rs[q] = 1.0f / sqrtf(rs[q] * (1.f / DM) + NORM_EPS);
#pragma unroll
        for (int j = 0; j < 4; ++j) { const int c = lane * 8 + 512 * j; float gs[8], sh[8], a[8], b[8], cc[8], d[8];
            { const f32x4 g0 = *(const GAS f32x4*)(g + c), g1 = *(const GAS f32x4*)(g + c + 4), s0 = *(const GAS f32x4*)(modx + sci * DM + c), s1 = *(const GAS f32x4*)(modx + sci * DM + c + 4);
              gs[0] = g0.x * (s0.x + 1.f); gs[1] = g0.y * (s0.y + 1.f); gs[2] = g0.z * (s0.z + 1.f); gs[3] = g0.w * (s0.w + 1.f); gs[4] = g1.x * (s1.x + 1.f); gs[5] = g1.y * (s1.y + 1.f); gs[6] = g1.z * (s1.z + 1.f); gs[7] = g1.w * (s1.w + 1.f); }
            { const f32x4 h0 = *(const GAS f32x4*)(modx + shi * DM + c), h1 = *(const GAS f32x4*)(modx + shi * DM + c + 4); sh[0] = h0.x; sh[1] = h0.y; sh[2] = h0.z; sh[3] = h0.w; sh[4] = h1.x; sh[5] = h1.y; sh[6] = h1.z; sh[7] = h1.w; }
            { float y0[8], y1[8], y2[8], y3[8]; unpack8(raw[0][j], y0); unpack8(raw[1][j], y1); unpack8(raw[2][j], y2); unpack8(raw[3][j], y3);
#pragma unroll
              for (int e = 0; e < 8; ++e) { a[e] = (y0[e] * rs[0]) * gs[e] + sh[e]; b[e] = (y1[e] * rs[1]) * gs[e] + sh[e]; cc[e] = (y2[e] * rs[2]) * gs[e] + sh[e]; d[e] = (y3[e] * rs[3]) * gs[e] + sh[e]; } }
            if (n == 0) {
                const float z8[8] = {0.f, 0.f, 0.f, 0.f, 0.f, 0.f, 0.f, 0.f}; const v4u w = pack8(a), wz = pack8(z8);
                *(GAS v4u*)(HQ + (size_t)0 * Q4 * DM + c) = w; *(GAS v4u*)(HQ + (size_t)1 * Q4 * DM + c) = w; *(GAS v4u*)(HQ + (size_t)2 * Q4 * DM + c) = wz; *(GAS v4u*)(HQ + (size_t)3 * Q4 * DM + c) = wz;
                *(GAS f32x4*)(HV + c) = (f32x4){cc[0], cc[1], cc[2], cc[3]}; *(GAS f32x4*)(HV + c + 4) = (f32x4){cc[4], cc[5], cc[6], cc[7]};
                *(GAS f32x4*)(HV + DM + c) = (f32x4){b[0] + d[0], b[1] + d[1], b[2] + d[2], b[3] + d[3]}; *(GAS f32x4*)(HV + DM + c + 4) = (f32x4){b[4] + d[4], b[5] + d[5], b[6] + d[6], b[7] + d[7]};
                *(GAS f32x4*)(HV + 2 * DM + c) = (f32x4){b[0] - d[0], b[1] - d[1], b[2] - d[2], b[3] - d[3]}; *(GAS f32x4*)(HV + 2 * DM + c + 4) = (f32x4){b[4] - d[4], b[5] - d[5], b[6] - d[6], b[7] - d[7]};
            } else {
                float s0[8], s1[8], s2[8], s3[8];
#pragma unroll
                for (int e = 0; e < 8; ++e) { const float ad = a[e] + d[e], bc = b[e] + cc[e], am = a[e] - d[e], bm = b[e] - cc[e]; s0[e] = ad + bc; s1[e] = ad - bc; s2[e] = am - bm; s3[e] = am + bm; }
                *(GAS v4u*)(HQ + ((size_t)0 * Q4 + n) * DM + c) = pack8(s0); *(GAS v4u*)(HQ + ((size_t)1 * Q4 + n) * DM + c) = pack8(s1);
                *(GAS v4u*)(HQ + ((size_t)2 * Q4 + n) * DM + c) = pack8(s2); *(GAS v4u*)(HQ + ((size_t)3 * Q4 + n) * DM + c) = pack8(s3);
            }
        }
    }
}
__device__ __forceinline__ void fourier_combine_rows(int gw, int NGW, const bf16* PQ4, const float* VV, const bf16* YS, bf16* F) {
    const int lane = lane_id_opaque(); asm volatile("" : "+s"(gw), "+s"(NGW));
    const float s8k = 0.011048543456039806f; constexpr int Q4 = SEQ / 4;
    for (int j = gw; j < Q4; j += NGW) {
        const float sj = (j & 1) ? -s8k : s8k;
        v4u pe_[4], po_[4], qe_[4], qo_[4];
#pragma unroll
        for (int jj = 0; jj < 4; ++jj) { const int c = lane * 8 + 512 * jj;
            pe_[jj] = *(const GAS v4u*)(PQ4 + ((size_t)0 * Q4 + j) * DM + c); po_[jj] = *(const GAS v4u*)(PQ4 + ((size_t)1 * Q4 + j) * DM + c);
            qe_[jj] = *(const GAS v4u*)(PQ4 + ((size_t)2 * Q4 + j) * DM + c); qo_[jj] = *(const GAS v4u*)(PQ4 + ((size_t)3 * Q4 + j) * DM + c); }
#pragma unroll
        for (int jj = 0; jj < 4; ++jj) {
            const int c = lane * 8 + 512 * jj;
            const v4u pe = pe_[jj], po = po_[jj], qe = qe_[jj], qo = qo_[jj];
            float v1[8], w1[8], w2[8];
            { const f32x4 a0 = *(const GAS f32x4*)(VV + c), a1 = *(const GAS f32x4*)(VV + c + 4), b0 = *(const GAS f32x4*)(VV + DM + c), b1 = *(const GAS f32x4*)(VV + DM + c + 4), c0 = *(const GAS f32x4*)(VV + 2 * DM + c), c1 = *(const GAS f32x4*)(VV + 2 * DM + c + 4);
              v1[0] = a0.x; v1[1] = a0.y; v1[2] = a0.z; v1[3] = a0.w; v1[4] = a1.x; v1[5] = a1.y; v1[6] = a1.z; v1[7] = a1.w;
              w1[0] = b0.x; w1[1] = b0.y; w1[2] = b0.z; w1[3] = b0.w; w1[4] = b1.x; w1[5] = b1.y; w1[6] = b1.z; w1[7] = b1.w;
              w2[0] = c0.x; w2[1] = c0.y; w2[2] = c0.z; w2[3] = c0.w; w2[4] = c1.x; w2[5] = c1.y; w2[6] = c1.z; w2[7] = c1.w; }
            v4u e_lo, e_hi, o_lo, o_hi;
#pragma unroll
            for (int e = 0; e < 4; ++e) {
                const float p0 = bflo(pe[e]) + sj * w1[2 * e], p1 = bfhi(pe[e]) + sj * w1[2 * e + 1], q0 = bflo(qe[e]), q1 = bfhi(qe[e]), t0 = s8k * v1[2 * e], t1 = s8k * v1[2 * e + 1];
                e_lo[e] = pk2(p0 - q0 + t0, p1 - q1 + t1); e_hi[e] = pk2(p0 + q0 + t0, p1 + q1 + t1);
                const float r0 = bflo(po[e]), r1 = bfhi(po[e]), u0 = bflo(qo[e]) + sj * w2[2 * e], u1 = bfhi(qo[e]) + sj * w2[2 * e + 1];
                o_lo[e] = pk2(r0 - u0 - t0, r1 - u1 - t1); o_hi[e] = pk2(r0 + u0 - t0, r1 + u1 - t1);
            }
            *(GAS v4u*)(F + (size_t)(2 * j) * DM + c) = e_lo;
            if (j != 0) *(GAS v4u*)(F + (size_t)(SEQ - 2 * j) * DM + c) = e_hi;
            *(GAS v4u*)(F + (size_t)(2 * j + 1) * DM + c) = o_lo;
            *(GAS v4u*)(F + (size_t)(SEQ - 2 * j - 1) * DM + c) = o_hi;
        }
    }
    for (int ch = gw; ch < DM; ch += NGW) {
        float a = 0.f;
#pragma unroll
        for (int jj = 0; jj < 4; ++jj) { const v4u y = *(const GAS v4u*)(YS + (size_t)ch * SEQ + lane * 8 + 512 * jj);
#pragma unroll
            for (int e = 0; e < 4; ++e) a += bflo(y[e]) - bfhi(y[e]); }
        a = wave_sum(a, lane);
        if (lane == 0) F[(size_t)(SEQ / 2) * DM + ch] = (bf16)f2bf(s8k * (a + VV[DM + ch] + VV[ch]));
    }
}
__device__ __forceinline__ void final_norm_rows(int gw, int NGW, const bf16* xs, const float* g, float* out) {
    const int lane = lane_id_opaque(); asm volatile("" : "+s"(gw), "+s"(NGW));
    for (int row = gw; row < SEQ; row += NGW) {
        float v[4][8]; float ss = 0.f;
#pragma unroll
        for (int j = 0; j < 4; ++j) { unpack8(*(const GAS v4u*)(xs + (size_t)(row + CTXL) * DM + lane * 8 + 512 * j), v[j]);
#pragma unroll
            for (int e = 0; e < 8; ++e) ss += v[j][e] * v[j][e]; }
        const float rstd = 1.0f / sqrtf(wave_sum(ss, lane) * (1.f / DM) + NORM_EPS);
#pragma unroll
        for (int j = 0; j < 4; ++j) { const int c = lane * 8 + 512 * j; const f32x4 g0 = *(const GAS f32x4*)(g + c), g1 = *(const GAS f32x4*)(g + c + 4);
            *(GAS f32x4*)(out + (size_t)row * DM + c) = (f32x4){v[j][0] * rstd * g0.x, v[j][1] * rstd * g0.y, v[j][2] * rstd * g0.z, v[j][3] * rstd * g0.w};
            *(GAS f32x4*)(out + (size_t)row * DM + c + 4) = (f32x4){v[j][4] * rstd * g1.x, v[j][5] * rstd * g1.y, v[j][6] * rstd * g1.z, v[j][7] * rstd * g1.w}; }
    }
}
__device__ __forceinline__ void conv_tail_rows(int gw, int NGW, const bf16* U, const bf16* U2, const float* cw, const float* cb, bf16* ACT) {
    const int lane = lane_id_opaque(); asm volatile("" : "+s"(gw), "+s"(NGW));
    constexpr int SR = 4;
    for (int it = gw; it < SEQ / SR; it += NGW) {
        const int R0 = CTXL + it * SR, c = 10 * 512 + lane * 8, ucol = (c >> 7) * 256 + (c & 127);
        v4u rv[SR + 2], rg[SR + 2], av[SR + 2], ag[SR + 2];
#pragma unroll
        for (int q = 0; q < SR + 2; ++q) { int row = R0 - 1 + q; row = row < CTXL ? CTXL : (row >= T ? T - 1 : row);
            const bf16* up = U + (size_t)row * NUP + ucol; const bf16* u2 = U2 + (size_t)(row - CTXL) * 1024 + (ucol - 40 * 256);
            rv[q] = *(const GAS v4u*)(up); rg[q] = *(const GAS v4u*)(up + 128); av[q] = *(const GAS v4u*)(u2); ag[q] = *(const GAS v4u*)(u2 + 128); }
        float wv[3][8], wg[3][8], bv[8], bg[8];
#pragma unroll
        for (int tp = 0; tp < 3; ++tp) { const f32x4 a0 = *(const GAS f32x4*)(cw + (size_t)tp * NUP + c), a1 = *(const GAS f32x4*)(cw + (size_t)tp * NUP + c + 4), g0 = *(const GAS f32x4*)(cw + (size_t)tp * NUP + DFF + c), g1 = *(const GAS f32x4*)(cw + (size_t)tp * NUP + DFF + c + 4);
            wv[tp][0] = a0.x; wv[tp][1] = a0.y; wv[tp][2] = a0.z; wv[tp][3] = a0.w; wv[tp][4] = a1.x; wv[tp][5] = a1.y; wv[tp][6] = a1.z; wv[tp][7] = a1.w;
            wg[tp][0] = g0.x; wg[tp][1] = g0.y; wg[tp][2] = g0.z; wg[tp][3] = g0.w; wg[tp][4] = g1.x; wg[tp][5] = g1.y; wg[tp][6] = g1.z; wg[tp][7] = g1.w; }
        { const f32x4 a0 = *(const GAS f32x4*)(cb + c), a1 = *(const GAS f32x4*)(cb + c + 4), g0 = *(const GAS f32x4*)(cb + DFF + c), g1 = *(const GAS f32x4*)(cb + DFF + c + 4);
            bv[0] = a0.x; bv[1] = a0.y; bv[2] = a0.z; bv[3] = a0.w; bv[4] = a1.x; bv[5] = a1.y; bv[6] = a1.z; bv[7] = a1.w;
            bg[0] = g0.x; bg[1] = g0.y; bg[2] = g0.z; bg[3] = g0.w; bg[4] = g1.x; bg[5] = g1.y; bg[6] = g1.z; bg[7] = g1.w; }
        const float z0 = (R0 == CTXL) ? 0.f : 1.f, z5 = (R0 + SR == T) ? 0.f : 1.f;
        float pv[8], pg[8], cv[8], cg[8];
        { float a[8], b[8]; unpack8(rv[0], a); unpack8(av[0], b);
#pragma unroll
          for (int e = 0; e < 8; ++e) pv[e] = (a[e] + b[e]) * z0;
          unpack8(rg[0], a); unpack8(ag[0], b);
#pragma unroll
          for (int e = 0; e < 8; ++e) pg[e] = (a[e] + b[e]) * z0;
          unpack8(rv[1], a); unpack8(av[1], b);
#pragma unroll
          for (int e = 0; e < 8; ++e) cv[e] = a[e] + b[e];
          unpack8(rg[1], a); unpack8(ag[1], b);
#pragma unroll
          for (int e = 0; e < 8; ++e) cg[e] = a[e] + b[e]; }
#pragma unroll
        for (int rr = 0; rr < SR; ++rr) {
            float nv[8], ng[8], o[8]; const float zn = (rr == SR - 1) ? z5 : 1.f;
            { float a[8], b[8]; unpack8(rv[rr + 2], a); unpack8(av[rr + 2], b);
#pragma unroll
              for (int e = 0; e < 8; ++e) nv[e] = (a[e] + b[e]) * zn;
              unpack8(rg[rr + 2], a); unpack8(ag[rr + 2], b);
#pragma unroll
              for (int e = 0; e < 8; ++e) ng[e] = (a[e] + b[e]) * zn; }
#pragma unroll
            for (int e = 0; e < 8; ++e) { const float v = pv[e] * wv[0][e] + cv[e] * wv[1][e] + nv[e] * wv[2][e] + bv[e], g = pg[e] * wg[0][e] + cg[e] * wg[1][e] + ng[e] * wg[2][e] + bg[e];
                o[e] = v * silu_f(g); pv[e] = cv[e]; pg[e] = cg[e]; cv[e] = nv[e]; cg[e] = ng[e]; }
            *(GAS v4u*)(ACT + (size_t)(R0 + rr) * DFF + c) = pack8(o);
        }
    }
}

__device__ __forceinline__ void conv_edge_rows(int gw, int NGW, int g_lo, int ncb, const float* EDGE, const float* cws, bf16* ACT) {
    const int lane = lane_id_opaque(); asm volatile("" : "+s"(gw), "+s"(NGW));
    const int nitems = (T / 256 - g_lo) * 2 * ncb;
    for (int it = gw; it < nitems; it += NGW) {
        const int ge = it / ncb, cbk = it - ge * ncb, g = g_lo + (ge >> 1), e = ge & 1, c = cbk * 512 + lane * 8;
        const bool nb = e == 0 ? (g >= 2) : (g != 0 && g != T / 256 - 1);
        const float* P = EDGE + (size_t)((g * 2 + e) * 2) * NUP + c;
        const float* R = EDGE + (size_t)(((e == 0 ? g - 1 : g + 1) * 2 + (1 - e)) * 2 + 1) * NUP + c;
        const float* wt = cws + (size_t)(e == 0 ? 0 : 2) * NUP + c;
        float o[8];
#pragma unroll
        for (int h = 0; h < 2; ++h) {
            f32x4 pv = *(const GAS f32x4*)(P + 4 * h), pg = *(const GAS f32x4*)(P + DFF + 4 * h);
            if (nb) { const f32x4 rv = *(const GAS f32x4*)(R + 4 * h), rg = *(const GAS f32x4*)(R + DFF + 4 * h), wv = *(const GAS f32x4*)(wt + 4 * h), wg = *(const GAS f32x4*)(wt + DFF + 4 * h);
                pv = pv + wv * rv; pg = pg + wg * rg; }
#pragma unroll
            for (int j = 0; j < 4; ++j) o[4 * h + j] = pv[j] * pg[j] * __builtin_amdgcn_rcpf(1.0f + __builtin_amdgcn_exp2f(pg[j]));
        }
        v4u w; w.x = pk2(o[0], o[1]); w.y = pk2(o[2], o[3]); w.z = pk2(o[4], o[5]); w.w = pk2(o[6], o[7]);
        *(GAS v4u*)(ACT + (size_t)(g * 256 + 255 * e) * DFF + c) = w;
    }
}

#ifndef REP_ATT
#define REP_ATT 1
#endif
#ifndef REP_UP
#define REP_UP 1
#endif
#ifndef REP_DFT
#define REP_DFT 1
#endif
#ifndef REP_PRO
#define REP_PRO 1
#endif
#ifndef REP_THIN
#define REP_THIN 1
#endif
struct Args { const float* in[20]; float* out; unsigned char* ws; };
typedef const __attribute__((address_space(4))) Args* kargs_t;
__device__ __forceinline__ kargs_t kargs() { kargs_t p = (kargs_t)__builtin_amdgcn_kernarg_segment_ptr(); asm volatile("" : "+s"(p)); return p; }
enum { I_X = 0, I_C, I_CTX, I_CCTX, I_ADAW, I_ADAB, I_N1G, I_N2G, I_WDQKV, I_QNG, I_KVNG, I_WUQ, I_WUKV, I_WO, I_FNOW, I_WUP, I_CONVW, I_CONVB, I_WDOWN, I_FNG };

__global__ void __launch_bounds__(NWAVES * 64, 2) fwd(Args args) {
    extern __shared__ __attribute__((aligned(16))) unsigned char lds[];
    LAS unsigned char* L = (LAS unsigned char*)lds;
    volatile LAS unsigned* MISC = (volatile LAS unsigned*)(L + MISC_OFF);
    const int tid = threadIdx.x, lane = tid & 63, wave = __builtin_amdgcn_readfirstlane(tid >> 6);
    const int G = gridDim.x, bx = blockIdx.x, vcu = (G % 8 == 0) ? (bx % 8) * (G / 8) + bx / 8 : bx;
    const int gw = vcu * NWAVES + wave, NGW = G * NWAVES;
    for (int u = tid; u < (LDS_BYTES - LDSCTL_OFF) / 4; u += NWAVES * 64) ((LAS unsigned*)(L + LDSCTL_OFF))[u] = 0u;
    __syncthreads();
    XcdBarrier bar = xcd_barrier_post((unsigned*)(kargs()->ws + WS_CTL) + CW_BAR, MISC + 8);
#define GRID_BAR() xcd_barrier(bar)

#define WSP(type, off) ((type*)(kargs()->ws + (off)))
#define IN(i) (kargs()->in[i])
#define MOD WSP(float, WS_MOD)
#define ROPE WSP(float, WS_ROPE)
#define WCT WSP(bf16, WS_WCT)
#define WCT4 WSP(bf16, WS_WCT4)
#define DSC WSP(bf16, WS_DSC)
#define DS WSP(bf16, WS_DS)
#define WDQ WSP(bf16, WS_WDQ)
#define WUQ WSP(bf16, WS_WUQ)
#define WUKV WSP(bf16, WS_WUKV)
#define WO WSP(bf16, WS_WO)
#define WFNO WSP(bf16, WS_WFNO)
#define WUP WSP(bf16, WS_WUP)
#define WDN WSP(bf16, WS_WDN)
#define XS WSP(bf16, WS_XS)
#define HN WSP(bf16, WS_HN)
#define SSQ WSP(float, WS_SSQ)
#define CQN WSP(bf16, WS_CQN)
#define CKVN WSP(bf16, WS_CKVN)
#define KR WSP(bf16, WS_KR)
#define Q WSP(bf16, WS_Q)
#define KV WSP(bf16, WS_KV)
#define O WSP(bf16, WS_O)
#define U WSP(bf16, WS_U)
#define ACT WSP(bf16, WS_ACT)
#define YT WSP(bf16, WS_YT)
#define YTC WSP(bf16, WS_YTC)
#define PART WSP(float, WS_PART)
#define U2C WSP(bf16, WS_U2C)
#define EDGE WSP(float, WS_EDGE)
#define CWS WSP(float, WS_CWS)
#define PQ WSP(bf16, WS_PQ)
#define H4B WSP(float, WS_H4)
#define V1B WSP(float, WS_V1)

    for (int rep = 0; rep < REP_PRO; ++rep) {
        LAS float* sx = (LAS float*)L;
        LAS float* red = (LAS float*)(L + 16384);
        for (int i = tid; i < DM; i += NWAVES * 64) { sx[i] = silu_f(IN(I_C)[i]); sx[DM + i] = silu_f(IN(I_CCTX)[i]); }
        __syncthreads();
        for (int it = bx; it < 256; it += G) {
            const int layer = it >> 6, n0 = (it & 63) * 192;
            f32x4 ax = {0.f, 0.f, 0.f, 0.f}, ac = {0.f, 0.f, 0.f, 0.f};
            if (lane < 48) {
                const float* W = IN(I_ADAW) + (size_t)layer * DM * (NMOD * DM) + n0 + lane * 4;
                for (int kk = 0; kk < 256; kk += 16) {
                    const int k = wave * 256 + kk; f32x4 w[16];
#pragma unroll
                    for (int u = 0; u < 16; ++u) w[u] = *(const GAS f32x4*)(W + (size_t)(k + u) * (NMOD * DM));
#pragma unroll
                    for (int u = 0; u < 16; ++u) { ax = ax + w[u] * sx[k + u]; ac = ac + w[u] * sx[DM + k + u]; }
                }
                *(LAS f32x4*)(red + (wave * 2 + 0) * 192 + lane * 4) = ax; *(LAS f32x4*)(red + (wave * 2 + 1) * 192 + lane * 4) = ac;
            }
            __syncthreads();
            if (tid < 384) { const int kind = tid / 192, col = tid - kind * 192; float s = IN(I_ADAB)[(size_t)layer * (NMOD * DM) + n0 + col];
#pragma unroll
                for (int w8 = 0; w8 < 8; ++w8) s += red[(w8 * 2 + kind) * 192 + col];
                MOD[(size_t)(layer * 2 + kind) * (NMOD * DM) + n0 + col] = s; }
            __syncthreads();
        }
        {
            LAS float* scr = (LAS float*)(L + RING_OFF + wave * 16384);
            constexpr int I_DQ = (DM / 64) * (NDQ / 32), I_UQ = (QL / 64) * (NUQ / 32), I_UKV = (KVL / 64) * (NUKV / 32), I_SQ = (DM / 64) * (DM / 32), I_UP = (DM / 64) * (NUP / 32), I_DN = (DFF / 64) * (DM / 32);
            constexpr int NITEMS = 2 * (I_DQ + I_UQ + I_UKV + I_SQ + I_SQ) + 4 * (I_UP + I_DN);
            for (int it = gw; it < NITEMS; it += NGW) {
                int r = it;
                if (r < 4 * I_UP) { const int l = r / I_UP; p0_transpose_item<2>(IN(I_WUP) + (size_t)l * DM * NUP, DM, NUP, WUP + (size_t)l * NUP * DM, scr, r - l * I_UP, lane); continue; } r -= 4 * I_UP;
                if (r < 4 * I_DN) { const int l = r / I_DN; p0_transpose_item<0>(IN(I_WDOWN) + (size_t)l * DFF * DM, DFF, DM, WDN + (size_t)l * DM * DFF, scr, r - l * I_DN, lane); continue; } r -= 4 * I_DN;
                if (r < 2 * I_DQ) { const int l = r / I_DQ; p0_transpose_item<3>(IN(I_WDQKV) + (size_t)l * DM * NDQ, DM, NDQ, WDQ + (size_t)l * NDQP * DM, scr, r - l * I_DQ, lane); continue; } r -= 2 * I_DQ;
                if (r < 2 * I_UQ) { const int l = r / I_UQ; p0_transpose_item<1>(IN(I_WUQ) + (size_t)l * QL * NUQ, QL, NUQ, WUQ + (size_t)l * NUQ * QL, scr, r - l * I_UQ, lane, IN(I_QNG) + (size_t)l * QL); continue; } r -= 2 * I_UQ;
                if (r < 2 * I_UKV) { const int l = r / I_UKV; p0_transpose_item<0>(IN(I_WUKV) + (size_t)l * KVL * NUKV, KVL, NUKV, WUKV + (size_t)l * NUKV * KVL, scr, r - l * I_UKV, lane, IN(I_KVNG) + (size_t)l * KVL); continue; } r -= 2 * I_UKV;
                if (r < 2 * I_SQ) { const int l = r / I_SQ; p0_transpose_item<0>(IN(I_WO) + (size_t)l * DM * DM, DM, DM, WO + (size_t)l * DM * DM, scr, r - l * I_SQ, lane); continue; } r -= 2 * I_SQ;
                { const int l = r / I_SQ; p0_transpose_item<0>(IN(I_FNOW) + (size_t)l * DM * DM, DM, DM, WFNO + (size_t)l * DM * DM, scr, r - l * I_SQ, lane); }
            }
            { const int per = (NDQP - NDQ) * DM / 8; const int gt = vcu * (NWAVES * 64) + tid, NT_ = G * NWAVES * 64;
              for (int i = gt; i < 2 * per; i += NT_) { const int l = i / per, e = i - l * per; *(GAS v4u*)(WDQ + (size_t)l * NDQP * DM + (size_t)NDQ * DM + (size_t)e * 8) = (v4u){0u, 0u, 0u, 0u}; } }
        }
        __syncthreads();
        {
            LAS float* tab = (LAS float*)L;
            for (int i = tid; i < 8192; i += NWAVES * 64) tab[i] = __builtin_amdgcn_cosf((float)i * (1.0f / 8192.0f));
            __syncthreads();
            const int gt = vcu * (NWAVES * 64) + tid, NT_ = G * NWAVES * 64;
            const float s8k = 0.011048543456039806f  , s16 = 0.0625f;
            for (int it = gt; it < 4 * (SEQ / 4) * (SEQ / 32); it += NT_) {
                const int per = (SEQ / 4) * (SEQ / 32), z = it / per, r = it - z * per, jj = r / (SEQ / 32), n0 = (r - jj * (SEQ / 32)) * 8, step = 2 * jj + (z & 1);
                int idx = (step * n0 + ((z >> 1) ? 8192 - 2048 : 0)) & 8191; float v[8];
#pragma unroll
                for (int e = 0; e < 8; ++e) { v[e] = tab[idx] * s8k; idx = (idx + step) & 8191; }
                v4u w; w.x = pk2(v[0], v[1]); w.y = pk2(v[2], v[3]); w.z = pk2(v[4], v[5]); w.w = pk2(v[6], v[7]);
                *(GAS v4u*)(DS + (size_t)z * (SEQ / 4) * (SEQ / 4) + (size_t)jj * (SEQ / 4) + n0) = w;
            }
            for (int it = gt; it < 1024 * 32; it += NT_) {
                const int r = it >> 5, c0 = (it & 31) * 8, l = r & 255, add = (r >= 512) ? (8192 - 2048) : 0; float v[8];
#pragma unroll
                for (int e = 0; e < 8; ++e) v[e] = tab[(l * (c0 + e) * 32 + add) & 8191] * s16;
                v4u w; w.x = pk2(v[0], v[1]); w.y = pk2(v[2], v[3]); w.z = pk2(v[4], v[5]); w.w = pk2(v[6], v[7]);
                *(GAS v4u*)(WCT4 + (size_t)r * 256 + c0) = w;
            }
            for (int it = gt; it < 512 * 32; it += NT_) {
                const int r = it >> 5, c0 = (it & 31) * 8, l = r & 255, add = (r >= 256) ? (8192 - 2048) : 0; float v[8];
#pragma unroll
                for (int e = 0; e < 8; ++e) v[e] = tab[(l * (c0 + e) * 32 + add) & 8191] * s16;
                v4u w; w.x = pk2(v[0], v[1]); w.y = pk2(v[2], v[3]); w.z = pk2(v[4], v[5]); w.w = pk2(v[6], v[7]);
                *(GAS v4u*)(WCT + (size_t)r * 256 + c0) = w;
            }
            for (int it = gt; it < 256 * 64; it += NT_) {
                const int k = it >> 6, n0 = (it & 63) * 8, add = (n0 >= 256) ? 2048 : 0; float v[8];
#pragma unroll
                for (int e = 0; e < 8; ++e) v[e] = tab[(k * ((n0 + e) & 255) * 32 + add) & 8191] * s16;
                v4u w; w.x = pk2(v[0], v[1]); w.y = pk2(v[2], v[3]); w.z = pk2(v[4], v[5]); w.w = pk2(v[6], v[7]);
                *(GAS v4u*)(DSC + (size_t)k * 512 + n0) = w;
            }
            for (int it = gt; it < DEPTH * 4 * NUP; it += NT_) {
                const int l = it / (4 * NUP), r = it - l * (4 * NUP), tp = r / NUP, n = r - tp * NUP;
                const float v = tp < 3 ? IN(I_CONVW)[((size_t)l * 3 + tp) * NUP + n] : IN(I_CONVB)[(size_t)l * NUP + n];
                CWS[it] = v * (n < DFF ? -0.6931471805599453f : -1.4426950408889634f);
            }
            for (int it = gt; it < SEQ * 32; it += NT_) {
                const int n = it >> 5, p = it & 31, half = p >> 4, j = p & 15;
                const float inv = __builtin_amdgcn_exp2f(-(float)j * (13.287712379549449f / 16.0f));
                const float ang = (float)(half ? (n & 63) : (n >> 6)) * inv;
                const float rev = ang * 0.15915494309189535f;
                const float fr = rev - floorf(rev);
                ROPE[(size_t)n * 64 + 2 * p] = __builtin_amdgcn_cosf(fr); ROPE[(size_t)n * 64 + 2 * p + 1] = __builtin_amdgcn_sinf(fr);
            }
        }
        GRID_BAR();
    }

    for (int layer = 0; layer < DEPTH; ++layer) {
        const bool mla = (layer & 1) == 0, ctx_adv = layer < 2;
        const int jm = layer >> 1;
        const float* modx = MOD + (size_t)(layer * 2 + 0) * (NMOD * DM); const float* modc = MOD + (size_t)(layer * 2 + 1) * (NMOD * DM);
        const int lo_tok = ctx_adv ? 0 : CTXL;
        const int nM_tok = (T - lo_tok) / 256;
        for (int rep = 0; rep < REP_THIN; ++rep) {
        if (mla) { norm_ctx_wg(vcu, G, wave, (LAS float*)(L + RING_OFF), XS, layer != 0, IN(I_CTX), IN(I_N1G) + (size_t)layer * DM, modc, 0, 1, HN, PART, (rep == 0 && layer == 2) ? DFF / 512 : 0);
                   norm_rows(gw, NGW, CTXL, T, XS, layer != 0, IN(I_X), IN(I_CTX), IN(I_N1G) + (size_t)layer * DM, modx, modc, 0, 1, HN, PART, 0); }
        else {
            if (ctx_adv) norm_ctx_wg(vcu, G, wave, (LAS float*)(L + RING_OFF), XS, true, nullptr, IN(I_N1G) + (size_t)layer * DM, modc, 0, 1, HN, PART, rep == 0 ? DFF / 512 : 0);
            norm_quad_rows(gw, NGW, XS, IN(I_N1G) + (size_t)layer * DM, modx, 0, 1, HN + (size_t)CTXL * DM, H4B);
        }
        }
        GRID_BAR();
        if (mla) {
            {
                pg8::Gemm g{HN, WDQ + (size_t)jm * NDQP * DM, DM, DM, DM, 0, 0, 0}; pg8::Order S; S.init(T / 256, NDQP / 256, 1, G, bx);
                pg8::EpiLatent E{CQN, CKVN, KR, SSQ, ROPE, CTXL, (LAS float*)(L + XCH_OFF)};
                pg8::gemm_phase<pg8::EpiLatent, pg8::Order, true, true>(L + RING_OFF, g, S, E, wave);
            }
            GRID_BAR();
            {
                const bf16* a0 = CQN + (size_t)lo_tok * QL; const bf16* b0 = WUQ + (size_t)jm * NUQ * QL; bf16* o0 = Q + (size_t)lo_tok * NUQ;
                pg8::Gemm g{a0, b0, QL, QL, QL, (long)((const char*)CKVN - (const char*)a0), (long)((const char*)(WUKV + (size_t)jm * NUKV * KVL) - (const char*)b0), 0};
                pg8::Order2 S; S.init(nM_tok, NUQ / 256, T / 256, NUKV / 256, G, bx);
                pg8::EpiBf16RS E{o0, NUQ, (long)(KV - o0), NUKV - NUQ, SSQ, lo_tok};
                pg8::gemm_phase<pg8::EpiBf16RS, pg8::Order2, true, true>(L + RING_OFF, g, S, E, wave);
            }
            GRID_BAR();
            {
                const int nunits = 512 + (ctx_adv ? 16 : 0); int vcu_ = vcu; asm volatile("" : "+s"(vcu_));
                for (int rep = 0; rep < REP_ATT; ++rep)
                for (int i = 0;; ++i) {
                    const int Lu = i * G + vcu_; if (Lu >= nunits) break;
                    int h, row0, seq, pos0; const float* rp;
                    if (Lu < 512) { h = Lu >> 5; const int qb = Lu & 31; row0 = CTXL + qb * 256; seq = T; pos0 = qb * 256; rp = ROPE; }
                    else { h = Lu - 512; row0 = 0; seq = CTXL; pos0 = 0; rp = nullptr; }
                    att::attn_unit(Q + (size_t)row0 * NUQ + h * 192, KV + h * 256, KV + h * 256 + 128, KR, O + (size_t)row0 * DM + h * 128, rp, pos0, seq, (char*)lds + RING_OFF, wave);
                }
            }
            GRID_BAR();
            {
                pg8::Gemm g{O + (size_t)CTXL * DM, WO + (size_t)jm * DM * DM, DM, DM, DM, 0, 0, 0}; pg8::Order S; S.init(SEQ / 256, DM / 256, 1, G, bx);
                pg8::EpiResid E{XS + (size_t)CTXL * DM, DM, modx + 2 * DM, modx + 2 * DM, 0};
                pg8::gemm_phase<pg8::EpiResid, pg8::Order, true, true>(L + RING_OFF, g, S, E, wave);
            }
            if (ctx_adv) {
                pg8::Gemm g{O, WO + (size_t)jm * DM * DM, DM, DM, 512, 512 * 2, 512 * 2, 0}; pg8::Order S; S.init(1, DM / 256, DM / 512, G, bx);
                pg8::EpiGatePart E{PART, DM, modc + 2 * DM};
                pg8::gemm_phase<pg8::EpiGatePart, pg8::Order, true, true>(L + RING_OFF, g, S, E, wave);
            }
            GRID_BAR();
        } else {
            if (bx < NG) {
                LAS float* h4s = (LAS float*)L; const int t_ = wave * 64 + lane_id_opaque();
                if (t_ < GC) { h4s[t_] = H4B[bx * GC + t_]; h4s[GC + t_] = H4B[DM + bx * GC + t_]; h4s[2 * GC + t_] = H4B[2 * DM + bx * GC + t_]; }
                __syncthreads();
                if (t_ < GC) { const bf16* wc_ = WCT + (size_t)t_ * GC; const bf16* ws_ = WCT + (size_t)(GC + t_) * GC; float a0 = 0.f, a1 = 0.f, a2 = 0.f;
                    for (int c = 0; c < GC; c += 8) { const v4u w = *(const GAS v4u*)(wc_ + c), x = *(const GAS v4u*)(ws_ + c);
#pragma unroll
                        for (int e = 0; e < 4; ++e) { a0 += bflo(w[e]) * h4s[c + 2 * e] + bfhi(w[e]) * h4s[c + 2 * e + 1]; a1 += bflo(w[e]) * h4s[GC + c + 2 * e] + bfhi(w[e]) * h4s[GC + c + 2 * e + 1];
                            a2 += bflo(x[e]) * h4s[2 * GC + c + 2 * e] + bfhi(x[e]) * h4s[2 * GC + c + 2 * e + 1]; } }
                    V1B[bx * GC + t_] = a0; V1B[DM + bx * GC + t_] = a1; V1B[2 * DM + bx * GC + t_] = a2; }
                __syncthreads();
            }
            {
                pg8::Gemm g{WCT4, HN + (size_t)CTXL * DM, GC, DM, GC, 0, (long)GC * 2, (long)(SEQ / 4) * DM * 2}; pg8::Order S; S.init(4, SEQ / 1024, NG, G, bx);
                pg8::EpiChDft E{YT, SEQ, SEQ / 4};
                pg8::gemm_phase<pg8::EpiChDft, pg8::Order, true, true>(L + RING_OFF, g, S, E, wave);
            }
            if (ctx_adv) {
                pg8::Gemm g{WCT, HN, GC, DM, GC, 0, (long)GC * 2, 0}; pg8::Order S; S.init(2, 1, NG, G, bx);
                pg8::EpiChDft E{YTC, 2 * CTXL, CTXL};
                pg8::gemm_phase<pg8::EpiChDft, pg8::Order, true, true>(L + RING_OFF, g, S, E, wave);
            }
            GRID_BAR();
            {
                pg8::Gemm g{DS, YT, SEQ / 4, SEQ, SEQ / 4, (long)(SEQ / 4) * (SEQ / 4) * 2, (long)(SEQ / 4) * 2, 0}; pg8::Order S; S.init(SEQ / 1024, DM / 256, 4, G, bx);
                pg8::EpiBf16 E{PQ, DM, (long)(SEQ / 4) * DM, 0};
                for (int rep = 0; rep < REP_DFT; ++rep)
                pg8::gemm_phase<pg8::EpiBf16, pg8::Order, true, true>(L + RING_OFF, g, S, E, wave);
            }
            if (ctx_adv) {
                pg8::Gemm g{DSC, YTC, 2 * CTXL, 2 * CTXL, 2 * CTXL, 0, 0, 0}; pg8::Order S; S.init(1, DM / 256, 1, G, bx);
                pg8::EpiBf16 E{O, DM, 0, 0};
                pg8::gemm_phase<pg8::EpiBf16, pg8::Order, true, true>(L + RING_OFF, g, S, E, wave);
            }
            GRID_BAR();
            for (int rep = 0; rep < REP_THIN; ++rep)
            fourier_combine_rows(gw, NGW, PQ, V1B, YT, O + (size_t)CTXL * DM);
            GRID_BAR();
            {
                pg8::Gemm g{O + (size_t)CTXL * DM, WFNO + (size_t)jm * DM * DM, DM, DM, DM, 0, 0, 0}; pg8::Order S; S.init(SEQ / 256, DM / 256, 1, G, bx);
                pg8::EpiResid E{XS + (size_t)CTXL * DM, DM, modx + 2 * DM, modx + 2 * DM, 0};
                pg8::gemm_phase<pg8::EpiResid, pg8::Order, true, true>(L + RING_OFF, g, S, E, wave);
            }
            if (ctx_adv) {
                pg8::Gemm g{O, WFNO + (size_t)jm * DM * DM, DM, DM, 512, 512 * 2, 512 * 2, 0}; pg8::Order S; S.init(1, DM / 256, DM / 512, G, bx);
                pg8::EpiGatePart E{PART, DM, modc + 2 * DM};
                pg8::gemm_phase<pg8::EpiGatePart, pg8::Order, true, true>(L + RING_OFF, g, S, E, wave);
            }
            GRID_BAR();
        }
        for (int rep = 0; rep < REP_THIN; ++rep)
        { if (ctx_adv) norm_ctx_wg(vcu, G, wave, (LAS float*)(L + RING_OFF), XS, true, nullptr, IN(I_N2G) + (size_t)layer * DM, modc, 3, 4, HN, PART, rep == 0 ? DM / 512 : 0);
          norm_rows(gw, NGW, CTXL, T, XS, true, nullptr, nullptr, IN(I_N2G) + (size_t)layer * DM, modx, modc, 3, 4, HN, PART, 0); }
        GRID_BAR();
        {
            { const int t_ = wave * 64 + lane_id_opaque(); if (t_ < 256) ((LAS float*)(L + XCH_OFF + 8192))[t_] = 0.f; }
            pg8::Gemm g{HN + (size_t)lo_tok * DM, WUP + (size_t)layer * NUP * DM, DM, DM, DM, 0, 0, 0}; pg8::Order S; S.init(nM_tok, ctx_adv ? 44 : 40, 1, G, bx);
            pg8::EpiConvGate E{ACT + (size_t)lo_tok * DFF, DFF, CWS + (size_t)layer * 4 * NUP, NUP, DFF, EDGE + (size_t)(lo_tok / 256) * 4 * NUP, (LAS float*)(L + XCH_OFF)};
            for (int rep = 0; rep < REP_UP; ++rep)
            pg8::gemm_phase<pg8::EpiConvGate, pg8::Order, true, true>(L + RING_OFF, g, S, E, wave);
        }
        if (!ctx_adv) {
            pg8::Gemm g{HN + (size_t)CTXL * DM, WUP + (size_t)layer * NUP * DM + (size_t)40 * 256 * DM, DM, DM, DM / 2, (long)(DM / 2) * 2, (long)(DM / 2) * 2, 0}; pg8::Order S; S.init(SEQ / 256, 4, 2, G, bx);
            pg8::EpiBf16 E{U + (size_t)CTXL * NUP + 40 * 256, NUP, (long)(U2C - (U + (size_t)CTXL * NUP + 40 * 256)), 1024 - NUP};
            for (int rep = 0; rep < REP_UP; ++rep)
            pg8::gemm_phase<pg8::EpiBf16, pg8::Order, true, true>(L + RING_OFF, g, S, E, wave);
        }
        GRID_BAR();
        for (int rep = 0; rep < REP_THIN; ++rep) {
            conv_edge_rows(gw, NGW, lo_tok / 256, ctx_adv ? 11 : 10, EDGE, CWS + (size_t)layer * 4 * NUP, ACT);
            if (!ctx_adv) conv_tail_rows(gw, NGW, U, U2C, IN(I_CONVW) + (size_t)layer * 3 * NUP, IN(I_CONVB) + (size_t)layer * NUP, ACT);
        }
        GRID_BAR();
        {
            pg8::Gemm g{ACT + (size_t)CTXL * DFF, WDN + (size_t)layer * DM * DFF, DFF, DFF, DFF, 0, 0, 0}; pg8::Order S; S.init(SEQ / 256, DM / 256, 1, G, bx);
            pg8::EpiResid E{XS + (size_t)CTXL * DM, DM, modx + 5 * DM, modx + 5 * DM, 0};
            pg8::gemm_phase<pg8::EpiResid, pg8::Order, true, true>(L + RING_OFF, g, S, E, wave);
        }
        if (ctx_adv) {
            pg8::Gemm g{ACT, WDN + (size_t)layer * DM * DFF, DFF, DFF, 512, 512 * 2, 512 * 2, 0}; pg8::Order S; S.init(1, DM / 256, DFF / 512, G, bx);
            pg8::EpiGatePart E{PART, DM, modc + 5 * DM};
            pg8::gemm_phase<pg8::EpiGatePart, pg8::Order, true, true>(L + RING_OFF, g, S, E, wave);
        }
        GRID_BAR();
    }
    final_norm_rows(gw, NGW, XS, IN(I_FNG), kargs()->out);
#undef GRID_BAR
#undef WSP
#undef IN
#undef MOD
#undef ROPE
#undef WCT
#undef WCT4
#undef DSC
#undef DS
#undef WDQ
#undef WUQ
#undef WUKV
#undef WO
#undef WFNO
#undef WUP
#undef WDN
#undef XS
#undef HN
#undef SSQ
#undef CQN
#undef CKVN
#undef KR
#undef Q
#undef KV
#undef O
#undef U
#undef ACT
#undef YT
#undef YTC
#undef PART
#undef U2C
#undef EDGE
#undef CWS
#undef PQ
#undef H4B
#undef V1B
}

extern "C" void kernel_launch(void* const* d_in, const int* in_sizes, int n_in, void* d_out, int out_size, void* d_ws, size_t ws_size, hipStream_t stream) {
    static int grid = 0;
    if (grid == 0) {
        if (n_in != 20 || in_sizes[0] != SEQ * DM || out_size != SEQ * DM || ws_size < WS_END) { fprintf(stderr, "kernel_launch: unexpected shapes: n_in %d in0 %d out %d ws %zu (need %zu)\n", n_in, n_in > 0 ? in_sizes[0] : -1, out_size, ws_size, (size_t)WS_END); grid = -1; return; }
        int dev = 0, cus = 0, per_cu = 0;
        if (hipGetDevice(&dev) != hipSuccess || hipDeviceGetAttribute(&cus, hipDeviceAttributeMultiprocessorCount, dev) != hipSuccess) { fprintf(stderr, "kernel_launch: device query failed\n"); grid = -1; return; }
        if (hipFuncSetAttribute((const void*)fwd, hipFuncAttributeMaxDynamicSharedMemorySize, LDS_BYTES) != hipSuccess) { fprintf(stderr, "kernel_launch: hipFuncSetAttribute failed\n"); grid = -1; return; }
        if (hipOccupancyMaxActiveBlocksPerMultiprocessor(&per_cu, (const void*)fwd, NWAVES * 64, LDS_BYTES) != hipSuccess || per_cu < 1)
            fprintf(stderr, "kernel_launch: note: occupancy query reports %d workgroups per CU\n", per_cu);
        (void)hipGetLastError();
        grid = cus;
    }
    if (grid < 0) return;
    if (hipMemsetAsync((char*)d_ws + WS_CTL, 0, CTL_ZERO_BYTES, stream) != hipSuccess) { fprintf(stderr, "kernel_launch: hipMemsetAsync failed\n"); return; }
    Args a{};
    for (int i = 0; i < 20; ++i) a.in[i] = (const float*)d_in[i];
    a.out = (float*)d_out; a.ws = (unsigned char*)d_ws;
    hipLaunchKernelGGL(fwd, dim3(grid), dim3(NWAVES * 64), LDS_BYTES, stream, a);
    const hipError_t le = hipPeekAtLastError();
    if (le != hipSuccess) fprintf(stderr, "kernel_launch: launch failed: %s\n", hipGetErrorName(le));
}
```
